# Optimizing an MI355X kernel written in HIP

```python
import math
import jax, jax.numpy as jnp
from jax import lax
import numpy as np

D_MODEL = 1024
BATCH = 8
SEQ = 4096
DEPTH = 2

EPS = 1e-6
ROPE_THETA = 500000.0
Q_BLOCK = 128

MLA_HEADS = 8
MLA_NOPE = 64
MLA_ROPE = 32
MLA_V = 64
Q_LORA = 384
KV_LORA = 256
MLA_WIDTH = MLA_HEADS * MLA_V

POOL_WINDOWS = (2, 4, 8, 16)
POOL_GROUP = 128
POOL_WIDTH = POOL_GROUP * len(POOL_WINDOWS)

IN_A = Q_LORA + KV_LORA + MLA_ROPE + POOL_WIDTH

DIFF_HEADS = 8
DIFF_HD = 64
DIFF_V = 2 * DIFF_HD
ROT_DIFF = DIFF_HD // 4
DIFF_QK_WIDTH = DIFF_HEADS * 2 * DIFF_HD
DIFF_V_WIDTH = DIFF_HEADS * DIFF_V

D_FF = -(-8 * D_MODEL // (3 * 256)) * 256

N_EVEN = (DEPTH + 1) // 2
N_ODD = DEPTH // 2

kernel_name = "hybrid_mla_pool_diffattn_adaln"


def rms_norm(x, g):
    xf = x.astype(jnp.float32)
    y = xf * lax.rsqrt(jnp.mean(xf * xf, axis=-1, keepdims=True) + EPS)
    return (y * g.astype(jnp.float32)).astype(x.dtype)


def rope_tables(positions, dim):
    inv = ROPE_THETA ** (-jnp.arange(0, dim, 2, dtype=jnp.float32) / dim)
    ang = positions.astype(jnp.float32)[..., None] * inv
    return jnp.cos(ang), jnp.sin(ang)


def apply_rope(x, cos, sin):
    x1, x2 = jnp.split(x, 2, axis=-1)
    cos = cos.astype(x.dtype)
    sin = sin.astype(x.dtype)
    return jnp.concatenate([x1 * cos - x2 * sin, x2 * cos + x1 * sin], axis=-1)


def query_blocks(t):
    b, s = t.shape[:2]
    t = t.reshape((b, s // Q_BLOCK, Q_BLOCK) + t.shape[2:])
    return jnp.moveaxis(t, 1, 0)


def merge_blocks(t):
    t = jnp.moveaxis(t, 0, 1)
    return t.reshape((t.shape[0], t.shape[1] * t.shape[2]) + t.shape[3:])


def causal_mask(blk, s):
    qpos = blk * Q_BLOCK + jnp.arange(Q_BLOCK)
    return jnp.arange(s)[None, :] <= qpos[:, None]


def mla_attention(q_nope, q_rope, k_nope, k_rope, v):
    s = k_nope.shape[1]
    scale = (MLA_NOPE + MLA_ROPE) ** -0.5

    def one_block(args):
        qn, qr, blk = args
        sc = (jnp.einsum('bqhd,bkhd->bhqk', qn, k_nope, preferred_element_type=jnp.float32)
              + jnp.einsum('bqhr,bkr->bhqk', qr, k_rope, preferred_element_type=jnp.float32))
        sc = jnp.where(causal_mask(blk, s), sc * scale, -jnp.inf)
        p = jax.nn.softmax(sc, axis=-1).astype(v.dtype)
        return jnp.einsum('bhqk,bkhd->bqhd', p, v)

    out = lax.map(one_block, (query_blocks(q_nope), query_blocks(q_rope),
                              jnp.arange(s // Q_BLOCK)))
    return merge_blocks(out)


def pool_mixer(u, w, b, scale):
    bsz, s, _ = u.shape
    uf = u.astype(jnp.float32)
    cs = jnp.cumsum(uf, axis=1)
    count = jnp.arange(1, s + 1, dtype=jnp.float32)[None, :, None]
    outs = []
    for g, win in enumerate(POOL_WINDOWS):
        csg = cs[..., g * POOL_GROUP:(g + 1) * POOL_GROUP]
        prev = jnp.pad(csg, ((0, 0), (win, 0), (0, 0)))[:, :s]
        mean = (csg - prev) / jnp.minimum(count, win)
        outs.append(mean - uf[..., g * POOL_GROUP:(g + 1) * POOL_GROUP])
    pooled = jnp.stack(outs, axis=2).astype(u.dtype)
    y = jnp.einsum('bsgc,gcd->bsgd', pooled, w) + b
    return y.reshape(bsz, s, POOL_WIDTH) * scale


def mla_pool_mixer(h, cos_r, sin_r, w_in, q_norm_g, kv_norm_g, w_uq, w_ukv,
                   p_w, p_b, p_scale, w_out):
    bsz, s, _ = h.shape
    proj = h @ w_in
    c_q, c_kv, k_rope, u = jnp.split(
        proj, [Q_LORA, Q_LORA + KV_LORA, Q_LORA + KV_LORA + MLA_ROPE], axis=-1)
    q = (rms_norm(c_q, q_norm_g) @ w_uq).reshape(bsz, s, MLA_HEADS, MLA_NOPE + MLA_ROPE)
    q_nope, q_rope = q[..., :MLA_NOPE], q[..., MLA_NOPE:]
    kv = (rms_norm(c_kv, kv_norm_g) @ w_ukv).reshape(bsz, s, MLA_HEADS, MLA_NOPE + MLA_V)
    k_nope, v = kv[..., :MLA_NOPE], kv[..., MLA_NOPE:]
    q_rope = apply_rope(q_rope, cos_r[:, :, None], sin_r[:, :, None])
    k_rope = apply_rope(k_rope, cos_r, sin_r)
    attn = mla_attention(q_nope, q_rope, k_nope, k_rope, v).reshape(bsz, s, MLA_WIDTH)
    pool = pool_mixer(u, p_w, p_b, p_scale)
    return jnp.concatenate([attn, pool], axis=-1) @ w_out


def diff_attention_mixer(h, cos_p, sin_p, w_qkv, lq1, lk1, lq2, lk2, subln_g, w_out,
                         lambda_init):
    bsz, s, _ = h.shape
    proj = h @ w_qkv
    q, k, v = jnp.split(proj, [DIFF_QK_WIDTH, 2 * DIFF_QK_WIDTH], axis=-1)
    q = q.reshape(bsz, s, DIFF_HEADS, 2, DIFF_HD)
    k = k.reshape(bsz, s, DIFF_HEADS, 2, DIFF_HD)
    v = v.reshape(bsz, s, DIFF_HEADS, DIFF_V)
    cp, sp = cos_p[:, :, None, None], sin_p[:, :, None, None]
    q = jnp.concatenate([apply_rope(q[..., :ROT_DIFF], cp, sp), q[..., ROT_DIFF:]], axis=-1)
    k = jnp.concatenate([apply_rope(k[..., :ROT_DIFF], cp, sp), k[..., ROT_DIFF:]], axis=-1)
    lam = (jnp.exp(jnp.sum(lq1.astype(jnp.float32) * lk1.astype(jnp.float32)))
           - jnp.exp(jnp.sum(lq2.astype(jnp.float32) * lk2.astype(jnp.float32)))
           + lambda_init)
    scale = DIFF_HD ** -0.5

    def one_block(args):
        qb, blk = args
        sc = jnp.einsum('bqhcd,bkhcd->bhcqk', qb, k, preferred_element_type=jnp.float32)
        sc = jnp.where(causal_mask(blk, s), sc * scale, -jnp.inf)
        p = jax.nn.softmax(sc, axis=-1)
        a = (p[:, :, 0] - lam * p[:, :, 1]).astype(v.dtype)
        return jnp.einsum('bhqk,bkhd->bqhd', a, v)

    out = merge_blocks(lax.map(one_block, (query_blocks(q), jnp.arange(s // Q_BLOCK))))
    out = rms_norm(out, subln_g) * (1.0 - lambda_init)
    return out.reshape(bsz, s, DIFF_V_WIDTH) @ w_out


def swiglu(h, w_gate_up, w_down):
    g, u = jnp.split(h @ w_gate_up, 2, axis=-1)
    return (jax.nn.silu(g) * u) @ w_down


def diff_lambda_init(layer_idx):
    return 0.8 - 0.6 * math.exp(-0.3 * layer_idx)


def setup_inputs(seed: int = 0) -> dict:
    key = jax.random.key(seed)
    ks = iter(jax.random.split(key, 32))

    def nrm(shape, scale):
        return jax.random.normal(next(ks), shape, jnp.float32) * scale

    def gain(shape):
        return 1.0 + nrm(shape, 0.05)

    D = D_MODEL
    x = nrm((BATCH, SEQ, D), 1.0)
    c = nrm((BATCH, D), 1.0)
    offsets = jax.random.randint(next(ks), (BATCH, 1), 0, 1024, dtype=jnp.int32)
    positions = (jnp.arange(SEQ, dtype=jnp.int32)[None, :] + offsets).astype(jnp.int32)
    return {
        "x": x,
        "c": c,
        "positions": positions,
        "ada_w": nrm((DEPTH, D, 6 * D), 0.5 * D ** -0.5),
        "ada_b": nrm((DEPTH, 6 * D), 0.02),
        "norm1_g": gain((DEPTH, D)),
        "norm2_g": gain((DEPTH, D)),
        "ffn_w_gate_up": nrm((DEPTH, D, 2 * D_FF), D ** -0.5),
        "ffn_w_down": nrm((DEPTH, D_FF, D), D_FF ** -0.5),
        "mla_w_in": nrm((N_EVEN, D, IN_A), D ** -0.5),
        "mla_q_norm_g": gain((N_EVEN, Q_LORA)),
        "mla_kv_norm_g": gain((N_EVEN, KV_LORA)),
        "mla_w_uq": nrm((N_EVEN, Q_LORA, MLA_HEADS * (MLA_NOPE + MLA_ROPE)), Q_LORA ** -0.5),
        "mla_w_ukv": nrm((N_EVEN, KV_LORA, MLA_HEADS * (MLA_NOPE + MLA_V)), KV_LORA ** -0.5),
        "pool_w": nrm((N_EVEN, len(POOL_WINDOWS), POOL_GROUP, POOL_GROUP), POOL_GROUP ** -0.5),
        "pool_b": nrm((N_EVEN, len(POOL_WINDOWS), POOL_GROUP), 0.02),
        "pool_scale": gain((N_EVEN, POOL_WIDTH)),
        "mix_a_w_out": nrm((N_EVEN, MLA_WIDTH + POOL_WIDTH, D), (MLA_WIDTH + POOL_WIDTH) ** -0.5),
        "diff_w_qkv": nrm((N_ODD, D, 2 * DIFF_QK_WIDTH + DIFF_V_WIDTH), D ** -0.5),
        "diff_lambda_q1": nrm((N_ODD, DIFF_HD), 0.1),
        "diff_lambda_k1": nrm((N_ODD, DIFF_HD), 0.1),
        "diff_lambda_q2": nrm((N_ODD, DIFF_HD), 0.1),
        "diff_lambda_k2": nrm((N_ODD, DIFF_HD), 0.1),
        "diff_subln_g": gain((N_ODD, DIFF_V)),
        "diff_w_out": nrm((N_ODD, DIFF_V_WIDTH, D), DIFF_V_WIDTH ** -0.5),
        "final_norm_g": gain((D,)),
    }


def reference(x, c, positions, ada_w, ada_b, norm1_g, norm2_g, ffn_w_gate_up, ffn_w_down,
              mla_w_in, mla_q_norm_g, mla_kv_norm_g, mla_w_uq, mla_w_ukv, pool_w, pool_b,
              pool_scale, mix_a_w_out, diff_w_qkv, diff_lambda_q1, diff_lambda_k1,
              diff_lambda_q2, diff_lambda_k2, diff_subln_g, diff_w_out, final_norm_g):
    cos_r, sin_r = rope_tables(positions, MLA_ROPE)
    cos_p, sin_p = rope_tables(positions, ROT_DIFF)
    cond = jax.nn.silu(c)
    for i in range(DEPTH):
        mod = cond @ ada_w[i] + ada_b[i]
        sh1, sc1, g1, sh2, sc2, g2 = [m[:, None, :] for m in jnp.split(mod, 6, axis=-1)]
        h = rms_norm(x, norm1_g[i]) * (1.0 + sc1) + sh1
        j = i // 2
        if i % 2 == 0:
            y = mla_pool_mixer(h, cos_r, sin_r, mla_w_in[j], mla_q_norm_g[j], mla_kv_norm_g[j],
                               mla_w_uq[j], mla_w_ukv[j], pool_w[j], pool_b[j],
                               pool_scale[j], mix_a_w_out[j])
        else:
            y = diff_attention_mixer(h, cos_p, sin_p, diff_w_qkv[j], diff_lambda_q1[j],
                                     diff_lambda_k1[j], diff_lambda_q2[j], diff_lambda_k2[j],
                                     diff_subln_g[j], diff_w_out[j], diff_lambda_init(i))
        x = x + g1 * y
        h = rms_norm(x, norm2_g[i]) * (1.0 + sc2) + sh2
        x = x + g2 * swiglu(h, ffn_w_gate_up[i], ffn_w_down[i])
    return rms_norm(x, final_norm_g)
```

```cpp
#include <hip/hip_runtime.h>
#include <hip/hip_cooperative_groups.h>
#include <cstdio>
#include <cstdint>
#include <cmath>
namespace cg = cooperative_groups;

namespace pg8 {
#define PG8_LAS __attribute__((address_space(3)))
typedef unsigned short bf16_t;
typedef short bf16x8 __attribute__((ext_vector_type(8)));
typedef float f32x4 __attribute__((ext_vector_type(4)));
typedef unsigned u32x4 __attribute__((ext_vector_type(4)));
constexpr int BM = 256, BK = 64, HALF = 128, HTB = HALF * BK * 2  , STAGE_BYTES = 8 * HTB, NXCD = 8, WGM = 8;

__host__ __device__ __forceinline__ int lds_byte(int r, int c) { const int st = (r >> 4) * 2 + (c >> 5), rr = r & 15, cc = c & 31, ob = rr * 64 + cc * 2; return st * 1024 + (ob ^ (((ob >> 9) & 1) << 5)); }
__host__ __device__ __forceinline__ void stage_rc(int b, int& R, int& C) { const int st = b / 1024, sb = b % 1024, swz = sb ^ (((sb >> 9) & 1) << 5); R = (st >> 1) * 16 + swz / 64; C = (st & 1) * 32 + (swz % 64) / 2; }
__host__ __device__ __forceinline__ int perm32(int rho) { const int n = rho >> 4, i = rho & 15; return 8 * (i >> 2) + 4 * n + (i & 3); }

struct Unit { int pm, pn; };
struct Gemm { const bf16_t* A; const bf16_t* Bt; int M, N, K; };

struct StaticOrder {
    int nM, nN, nwg, G, c;
    __host__ __device__ void init(int M, int N, int G_, int c_) { nM = M / BM; nN = N / BM; nwg = nM * nN; G = G_; c = c_; }
    __host__ __device__ bool next(int i, Unit& u) const {
        const long L = (long)i * G + c; if (L >= nwg) return false;
        int wgid = (int)L; { const int q = nwg / NXCD, r = nwg % NXCD, xcd = wgid % NXCD, off = wgid / NXCD; wgid = (xcd < r ? xcd * (q + 1) : r * (q + 1) + (xcd - r) * q) + off; }
        const int nig = WGM * nN, gid = wgid / nig, fm = gid * WGM, gsz = (nM - fm) < WGM ? (nM - fm) : WGM;
        u.pm = fm + ((wgid % nig) % gsz); u.pn = (wgid % nig) / gsz; return true;
    }
    __device__ __forceinline__ void a_ready(const Unit&) const {}
    __device__ __forceinline__ void done(const Unit&) const {}
};

__device__ __forceinline__ unsigned cvt_pk_bf16(float lo, float hi) { unsigned r; asm volatile("v_cvt_pk_bf16_f32 %0, %1, %2" : "=v"(r) : "v"(lo), "v"(hi)); return r; }
typedef unsigned u32x2 __attribute__((ext_vector_type(2)));
typedef float f32x2 __attribute__((ext_vector_type(2)));
template <class Epi, class Sched, bool ALIGN_EPI = false, bool SP2 = false>
__device__ __forceinline__ void gemm_phase(PG8_LAS unsigned char* lds, const Gemm g, const Sched& S, const Epi& E) {
    int tid_ = threadIdx.x; asm volatile("" : "+v"(tid_));
    const int tid = tid_, wid = __builtin_amdgcn_readfirstlane(tid >> 6), lane = tid & 63, wr = wid >> 2, wc = wid & 3, fr = lane & 15, fq = lane >> 4;
    int K_ = g.K; asm volatile("" : "+s"(K_));
    const int K = K_, nt = K / BK;
    unsigned voffA[2], voffB[2];
#pragma unroll
    for (int i = 0; i < 2; ++i) { int R, C; stage_rc(tid * 16 + i * 8192, R, C); const int Rb = Epi::PERM ? ((R & ~31) + perm32(R & 31)) : R;
        voffA[i] = (unsigned)(R * K + C) * 2u; voffB[i] = (unsigned)(Rb * K + C) * 2u; }
    const size_t kstep = (size_t)(BK * 2);
    const size_t hstep = (size_t)HALF * K * 2;
    const size_t tstep = 2 * hstep;
    const unsigned ldsw = (unsigned)wid * 1024u;
    const int aoff = lds_byte(wr * 64 + fr, fq * 8), boff = lds_byte(wc * 32 + fr, fq * 8);
#define PG8_SA(b, h) (((b) * 2 + (h)) * HTB)
#define PG8_SB(b, h) ((4 + (b) * 2 + (h)) * HTB)
#define PG8_STAGE(bufoff, gbase, voff) do { _Pragma("unroll") for (int _i = 0; _i < 2; ++_i) \
        __builtin_amdgcn_global_load_lds((const unsigned*)((const char*)(gbase) + (voff)[_i]), (PG8_LAS unsigned*)(lds + (bufoff) + ldsw + _i * 8192), 16, 0, 0); } while (0)
#define PG8_LDA(dst, b, h) do { _Pragma("unroll") for (int m = 0; m < 4; ++m) _Pragma("unroll") for (int k = 0; k < 2; ++k) dst[m][k] = *(const PG8_LAS bf16x8*)(lds + PG8_SA(b, h) + aoff + m * 2048 + k * 1024); } while (0)
#define PG8_LDB(dst, b, h) do { _Pragma("unroll") for (int n = 0; n < 2; ++n) _Pragma("unroll") for (int k = 0; k < 2; ++k) dst[n][k] = *(const PG8_LAS bf16x8*)(lds + PG8_SB(b, h) + boff + n * 2048 + k * 1024); } while (0)
#define PG8_MMA(ai, bj, At, Bt) do { __builtin_amdgcn_s_setprio(1); _Pragma("unroll") for (int m = 0; m < 4; ++m) _Pragma("unroll") for (int n = 0; n < 2; ++n) _Pragma("unroll") for (int k = 0; k < 2; ++k) \
        acc[ai][bj][m][n] = __builtin_amdgcn_mfma_f32_16x16x32_bf16(Bt[n][k], At[m][k], acc[ai][bj][m][n], 0, 0, 0); __builtin_amdgcn_s_setprio(0); } while (0)
#define PG8_WAIT_V(n) asm volatile("s_waitcnt vmcnt(" #n ")" ::: "memory")
#define PG8_WAIT_L(n) asm volatile("s_waitcnt lgkmcnt(" #n ")" ::: "memory")
#define PG8_BAR __builtin_amdgcn_s_barrier()
#define PG8_SCHED __builtin_amdgcn_sched_barrier(0)
    Unit cur, nxt; int ui = 0;
    if (!S.next(0, cur)) return;
    f32x4 acc[2][2][4][2];
#pragma unroll
    for (int a = 0; a < 2; ++a)
#pragma unroll
        for (int b = 0; b < 2; ++b)
#pragma unroll
            for (int m = 0; m < 4; ++m)
#pragma unroll
                for (int n = 0; n < 2; ++n) acc[a][b][m][n] = (f32x4){0.f, 0.f, 0.f, 0.f};
    bf16x8 At[4][2], B0[2][2], B1[2][2];
    const char* cA = (const char*)g.A + (size_t)cur.pm * tstep; const char* cB = (const char*)g.Bt + (size_t)cur.pn * tstep;
    S.a_ready(cur);
    if constexpr (SP2) {
        PG8_STAGE(PG8_SB(0, 0), cB, voffB); PG8_STAGE(PG8_SB(0, 1), cB + hstep, voffB); PG8_STAGE(PG8_SA(0, 0), cA, voffA); PG8_STAGE(PG8_SA(0, 1), cA + hstep, voffA);
        if (wr == 1) PG8_BAR;
        PG8_WAIT_V(2); PG8_BAR;
        PG8_STAGE(PG8_SB(1, 0), cB + kstep, voffB); PG8_STAGE(PG8_SA(1, 0), cA + kstep, voffA); PG8_STAGE(PG8_SB(1, 1), cB + hstep + kstep, voffB);
        PG8_WAIT_V(6); PG8_BAR;
    } else {
        PG8_STAGE(PG8_SB(0, 0), cB, voffB); PG8_STAGE(PG8_SA(0, 0), cA, voffA); PG8_STAGE(PG8_SB(0, 1), cB + hstep, voffB); PG8_STAGE(PG8_SA(0, 1), cA + hstep, voffA);
        if (wr == 1) PG8_BAR;
        PG8_WAIT_V(4); PG8_BAR;
        PG8_STAGE(PG8_SB(1, 0), cB + kstep, voffB); PG8_STAGE(PG8_SA(1, 0), cA + kstep, voffA); PG8_STAGE(PG8_SB(1, 1), cB + hstep + kstep, voffB);
        PG8_WAIT_V(6); PG8_BAR;
    }
    for (;;) {
        const bool has_next = S.next(ui + 1, nxt);
        const char* nA = has_next ? (const char*)g.A + (size_t)nxt.pm * tstep : cA; const char* nB = has_next ? (const char*)g.Bt + (size_t)nxt.pn * tstep : cB;
        for (int t = 0; t < nt; t += 2) {
            const bool last = (t == nt - 2);
            const char* a1 = cA + (size_t)(t + 1) * kstep;
            const char* a2 = last ? nA : cA + (size_t)(t + 2) * kstep; const char* b2 = last ? nB : cB + (size_t)(t + 2) * kstep;
            const char* a3 = a2 + kstep; const char* b3 = b2 + kstep;
            if (last && has_next) S.a_ready(nxt);
            if constexpr (SP2) {
            PG8_LDB(B0, 0, 0); PG8_LDB(B1, 0, 1); PG8_SCHED; PG8_LDA(At, 0, 0); PG8_STAGE(PG8_SA(1, 1), a1 + hstep, voffA);
            PG8_WAIT_V(8); PG8_WAIT_L(0); PG8_BAR; PG8_MMA(0, 0, At, B0); PG8_MMA(0, 1, At, B1); PG8_BAR; PG8_SCHED;
            PG8_LDA(At, 0, 1); PG8_STAGE(PG8_SB(0, 0), b2, voffB); PG8_STAGE(PG8_SB(0, 1), b2 + hstep, voffB); PG8_STAGE(PG8_SA(0, 0), a2, voffA);
            PG8_WAIT_V(8); PG8_WAIT_L(0); PG8_BAR; PG8_MMA(1, 0, At, B0); PG8_MMA(1, 1, At, B1); PG8_BAR; PG8_SCHED;
            PG8_LDB(B0, 1, 0); PG8_LDB(B1, 1, 1); PG8_SCHED; PG8_LDA(At, 1, 0); PG8_STAGE(PG8_SA(0, 1), a2 + hstep, voffA);
            PG8_WAIT_V(8); PG8_WAIT_L(0); PG8_BAR; PG8_MMA(0, 0, At, B0); PG8_MMA(0, 1, At, B1); PG8_BAR; PG8_SCHED;
            PG8_LDA(At, 1, 1); PG8_STAGE(PG8_SB(1, 0), b3, voffB); PG8_STAGE(PG8_SB(1, 1), b3 + hstep, voffB); PG8_STAGE(PG8_SA(1, 0), a3, voffA);
            PG8_WAIT_V(8); PG8_WAIT_L(0); PG8_BAR; PG8_MMA(1, 0, At, B0); PG8_MMA(1, 1, At, B1); PG8_BAR; PG8_SCHED;
            } else {
            PG8_LDB(B0, 0, 0); PG8_SCHED; PG8_LDA(At, 0, 0); PG8_STAGE(PG8_SA(1, 1), a1 + hstep, voffA);
            PG8_WAIT_L(8); PG8_BAR; PG8_WAIT_L(0); PG8_MMA(0, 0, At, B0); PG8_BAR; PG8_SCHED;
            PG8_LDB(B1, 0, 1); PG8_STAGE(PG8_SB(0, 0), b2, voffB);
            PG8_BAR; PG8_WAIT_L(0); PG8_MMA(0, 1, At, B1); PG8_BAR;
            PG8_LDA(At, 0, 1); PG8_STAGE(PG8_SA(0, 0), a2, voffA);
            PG8_BAR; PG8_WAIT_L(0); PG8_MMA(1, 0, At, B0); PG8_BAR; PG8_SCHED;
            PG8_STAGE(PG8_SB(0, 1), b2 + hstep, voffB);
            PG8_WAIT_V(6); PG8_BAR; PG8_MMA(1, 1, At, B1); PG8_BAR;
            PG8_LDB(B0, 1, 0); PG8_SCHED; PG8_LDA(At, 1, 0); PG8_STAGE(PG8_SA(0, 1), a2 + hstep, voffA);
            PG8_WAIT_L(8); PG8_BAR; PG8_WAIT_L(0); PG8_MMA(0, 0, At, B0); PG8_BAR; PG8_SCHED;
            PG8_LDB(B1, 1, 1); PG8_STAGE(PG8_SB(1, 0), b3, voffB);
            PG8_BAR; PG8_WAIT_L(0); PG8_MMA(0, 1, At, B1); PG8_BAR;
            PG8_LDA(At, 1, 1); PG8_STAGE(PG8_SA(1, 0), a3, voffA);
            PG8_BAR; PG8_WAIT_L(0); PG8_MMA(1, 0, At, B0); PG8_BAR; PG8_SCHED;
            PG8_STAGE(PG8_SB(1, 1), b3 + hstep, voffB);
            PG8_WAIT_V(6); PG8_BAR; PG8_MMA(1, 1, At, B1); PG8_BAR;
            }
        }
        if constexpr (ALIGN_EPI) { if (wr == 0) PG8_BAR; }
        if constexpr (!Epi::AFTER_DRAIN) { int l2_ = threadIdx.x; asm volatile("" : "+v"(l2_)); l2_ &= 63; E(acc, cur, wr, wc, l2_ & 15, l2_ >> 4); S.done(cur); }
        if (!has_next) break;
#pragma unroll
        for (int a = 0; a < 2; ++a)
#pragma unroll
            for (int b = 0; b < 2; ++b)
#pragma unroll
                for (int m = 0; m < 4; ++m)
#pragma unroll
                    for (int n = 0; n < 2; ++n) acc[a][b][m][n] = (f32x4){0.f, 0.f, 0.f, 0.f};
        cur = nxt; cA = nA; cB = nB; ++ui;
        if constexpr (ALIGN_EPI) { if (wr == 1) PG8_BAR; }
    }
    PG8_WAIT_V(0);
    if constexpr (!ALIGN_EPI) { if (wr == 0) PG8_BAR; }
    PG8_BAR;
    if constexpr (Epi::AFTER_DRAIN) { E.fused(acc, cur, wr, wc, fr, fq, lds, wid, lane); S.done(cur); }
#undef PG8_SA
#undef PG8_SB
#undef PG8_STAGE
#undef PG8_LDA
#undef PG8_LDB
#undef PG8_MMA
#undef PG8_WAIT_V
#undef PG8_WAIT_L
#undef PG8_BAR
#undef PG8_SCHED
}

struct EpiStore {
    static constexpr bool PERM = true, AFTER_DRAIN = false;
    bf16_t* O; int ldc; const float* bias; const float* cs;
    __device__ __forceinline__ void operator()(const f32x4 (&acc)[2][2][4][2], const Unit& u, int wr, int wc, int fr, int fq) const {
        const int row0 = u.pm * BM + wr * 64 + fr, col0 = u.pn * BM + wc * 32 + 8 * fq;
        f32x4 bv[2][2], sv[2][2];
#pragma unroll
        for (int bj = 0; bj < 2; ++bj)
#pragma unroll
            for (int n = 0; n < 2; ++n) { bv[bj][n] = bias ? *(const f32x4*)(bias + col0 + bj * HALF + 4 * n) : (f32x4){0.f, 0.f, 0.f, 0.f};
                                          sv[bj][n] = cs ? *(const f32x4*)(cs + col0 + bj * HALF + 4 * n) : (f32x4){1.f, 1.f, 1.f, 1.f}; }
#pragma unroll
        for (int ai = 0; ai < 2; ++ai)
#pragma unroll
            for (int m = 0; m < 4; ++m) { bf16_t* rowp = O + (size_t)(row0 + ai * HALF + m * 16) * ldc + col0;
#pragma unroll
                for (int bj = 0; bj < 2; ++bj) { const f32x4 v0 = (acc[ai][bj][m][0] + bv[bj][0]) * sv[bj][0], v1 = (acc[ai][bj][m][1] + bv[bj][1]) * sv[bj][1];
                    u32x4 w; w.x = cvt_pk_bf16(v0[0], v0[1]); w.y = cvt_pk_bf16(v0[2], v0[3]); w.z = cvt_pk_bf16(v1[0], v1[1]); w.w = cvt_pk_bf16(v1[2], v1[3]);
                    *(u32x4*)(rowp + bj * HALF) = w; } }
    }
};
struct EpiKvHead {
    static constexpr bool PERM = true, AFTER_DRAIN = false;
    bf16_t* O;
    __device__ __forceinline__ void operator()(const f32x4 (&acc)[2][2][4][2], const Unit& u, int wr, int wc, int fr, int fq) const {
        const int row0 = u.pm * BM + wr * 64 + fr, col0 = u.pn * BM + wc * 32 + 8 * fq;
#pragma unroll
        for (int ai = 0; ai < 2; ++ai)
#pragma unroll
            for (int m = 0; m < 4; ++m) { const int row = row0 + ai * HALF + m * 16; const size_t bs = (size_t)(row >> 12), sq = (size_t)(row & 4095);
#pragma unroll
                for (int bj = 0; bj < 2; ++bj) { const int col = col0 + bj * HALF; const f32x4 v0 = acc[ai][bj][m][0], v1 = acc[ai][bj][m][1];
                    u32x4 w; w.x = cvt_pk_bf16(v0[0], v0[1]); w.y = cvt_pk_bf16(v0[2], v0[3]); w.z = cvt_pk_bf16(v1[0], v1[1]); w.w = cvt_pk_bf16(v1[2], v1[3]);
                    *(u32x4*)(O + (size_t)((col >> 6) & 1) * 16777216 + ((bs * 8 + (col >> 7)) * 4096 + sq) * 64 + (col & 63)) = w; } }
    }
};
struct EpiSwiglu {
    static constexpr bool PERM = true, AFTER_DRAIN = false;
    bf16_t* O; int ldc; const float* SS; const float* bt;
    __device__ __forceinline__ static float sg(float g, float u) { return g * u * __builtin_amdgcn_rcpf(1.0f + __builtin_amdgcn_exp2f(-1.4426950408889634f * g)); }
    __device__ __forceinline__ void operator()(const f32x4 (&acc)[2][2][4][2], const Unit& u, int wr, int wc, int fr, int fq) const {
        const int row0 = u.pm * BM + wr * 64 + fr, col0 = u.pn * BM + wc * 32 + 8 * fq, j0 = u.pn * HALF + wc * 32 + 8 * fq;
        const float* bp = bt + (size_t)((u.pm * BM) >> 12) * (2 * 2816) + col0;
        f32x4 bv[2][2];
#pragma unroll
        for (int bj = 0; bj < 2; ++bj)
#pragma unroll
            for (int n = 0; n < 2; ++n) bv[bj][n] = *(const f32x4*)(bp + bj * HALF + 4 * n);
#pragma unroll
        for (int ai = 0; ai < 2; ++ai)
#pragma unroll
            for (int m = 0; m < 4; ++m) { const int row = row0 + ai * HALF + m * 16;
                const float rstd = __builtin_amdgcn_rsqf(SS[row] * (1.0f / 1024.0f) + 1e-6f);
                const f32x4 g0 = acc[ai][0][m][0] * rstd + bv[0][0], g1 = acc[ai][0][m][1] * rstd + bv[0][1], u0 = acc[ai][1][m][0] * rstd + bv[1][0], u1 = acc[ai][1][m][1] * rstd + bv[1][1];
                u32x4 w; w.x = cvt_pk_bf16(sg(g0[0], u0[0]), sg(g0[1], u0[1])); w.y = cvt_pk_bf16(sg(g0[2], u0[2]), sg(g0[3], u0[3]));
                w.z = cvt_pk_bf16(sg(g1[0], u1[0]), sg(g1[1], u1[1])); w.w = cvt_pk_bf16(sg(g1[2], u1[2]), sg(g1[3], u1[3]));
                *(u32x4*)(O + (size_t)row * ldc + j0) = w; }
    }
};
struct EpiRes {
    static constexpr bool PERM = true, AFTER_DRAIN = false;
    const float* base; float* out; const float* gate; int gstride;
    __device__ __forceinline__ void operator()(const f32x4 (&acc)[2][2][4][2], const Unit& u, int wr, int wc, int fr, int fq) const {
        const int row0 = u.pm * BM + wr * 64 + fr, col0 = u.pn * BM + wc * 32 + 8 * fq;
        const float* gp = gate + (size_t)((u.pm * BM) >> 12) * gstride;
#pragma unroll
        for (int bj = 0; bj < 2; ++bj) { const int col = col0 + bj * HALF; const f32x4 g0 = *(const f32x4*)(gp + col), g1 = *(const f32x4*)(gp + col + 4);
#pragma unroll
            for (int ai = 0; ai < 2; ++ai)
#pragma unroll
                for (int m = 0; m < 4; ++m) { const size_t off = (size_t)(row0 + ai * HALF + m * 16) * 1024 + col;
                    *(f32x4*)(out + off) = *(const f32x4*)(base + off) + g0 * acc[ai][bj][m][0]; *(f32x4*)(out + off + 4) = *(const f32x4*)(base + off + 4) + g1 * acc[ai][bj][m][1]; }
            asm volatile("" ::: "memory"); }
    }
};
struct EpiResN {
    static constexpr bool PERM = true, AFTER_DRAIN = false;
    const float* base; float* out; const float* gate; int gstride; bf16_t* XA; const float* atab; float* SS;
    __device__ __forceinline__ void operator()(const f32x4 (&acc)[2][2][4][2], const Unit& u, int wr, int wc, int fr, int fq) const {
        const int row0 = u.pm * BM + wr * 64 + fr, col0 = u.pn * BM + wc * 32 + 8 * fq; const int b = (u.pm * BM) >> 12;
        const float* gp = gate + (size_t)b * gstride; const float* ap = atab + (size_t)b * 1024;
        float ssq[2][4];
#pragma unroll
        for (int ai = 0; ai < 2; ++ai)
#pragma unroll
            for (int m = 0; m < 4; ++m) ssq[ai][m] = 0.f;
#pragma unroll
        for (int bj = 0; bj < 2; ++bj) { const int col = col0 + bj * HALF;
            const f32x4 g0 = *(const f32x4*)(gp + col), g1 = *(const f32x4*)(gp + col + 4), a0 = *(const f32x4*)(ap + col), a1 = *(const f32x4*)(ap + col + 4);
#pragma unroll
            for (int ai = 0; ai < 2; ++ai)
#pragma unroll
                for (int m = 0; m < 4; ++m) { const size_t off = (size_t)(row0 + ai * HALF + m * 16) * 1024 + col;
                    const f32x4 x0 = *(const f32x4*)(base + off) + g0 * acc[ai][bj][m][0], x1 = *(const f32x4*)(base + off + 4) + g1 * acc[ai][bj][m][1];
                    *(f32x4*)(out + off) = x0; *(f32x4*)(out + off + 4) = x1;
                    ssq[ai][m] += ((x0[0] * x0[0] + x0[1] * x0[1]) + (x0[2] * x0[2] + x0[3] * x0[3])) + ((x1[0] * x1[0] + x1[1] * x1[1]) + (x1[2] * x1[2] + x1[3] * x1[3]));
                    const f32x4 y0 = x0 * a0, y1 = x1 * a1; u32x4 w; w.x = cvt_pk_bf16(y0[0], y0[1]); w.y = cvt_pk_bf16(y0[2], y0[3]); w.z = cvt_pk_bf16(y1[0], y1[1]); w.w = cvt_pk_bf16(y1[2], y1[3]);
                    *(u32x4*)(XA + off) = w; }
            asm volatile("" ::: "memory"); }
#pragma unroll
        for (int ai = 0; ai < 2; ++ai)
#pragma unroll
            for (int m = 0; m < 4; ++m) { float s = ssq[ai][m]; s += __shfl_xor(s, 16); s += __shfl_xor(s, 32);
                if (fq == 0) atomicAdd(SS + row0 + ai * HALF + m * 16, s); }
    }
};
struct EpiQMla {
    static constexpr bool PERM = true, AFTER_DRAIN = false;
    bf16_t* O; const float* cosr; const float* sinr; float qscale;
    __device__ __forceinline__ void operator()(const f32x4 (&acc)[2][2][4][2], const Unit& u, int wr, int wc, int fr, int fq) const {
        const int row0 = u.pm * BM + wr * 64 + fr;
        const int cb0 = u.pn * BM + wc * 32, cb1 = cb0 + HALF; const bool rope0 = ((cb0 >> 5) % 3) == 2, rope1 = ((cb1 >> 5) % 3) == 2;
#pragma unroll
        for (int ai = 0; ai < 2; ++ai)
#pragma unroll
            for (int m = 0; m < 4; ++m) { const int row = row0 + ai * HALF + m * 16;
                f32x4 c = (f32x4){1.f, 1.f, 1.f, 1.f}, s = (f32x4){0.f, 0.f, 0.f, 0.f};
                if (rope0 || rope1) { c = *(const f32x4*)(cosr + (size_t)row * 16 + 4 * fq); s = *(const f32x4*)(sinr + (size_t)row * 16 + 4 * fq); }
#pragma unroll
                for (int bj = 0; bj < 2; ++bj) { const bool rope = bj ? rope1 : rope0; f32x4 a = acc[ai][bj][m][0], b = acc[ai][bj][m][1];
                    if (rope) { const f32x4 a2 = (f32x4){a[0] * c[0] - a[1] * s[0], a[1] * c[0] + a[0] * s[0], a[2] * c[1] - a[3] * s[1], a[3] * c[1] + a[2] * s[1]};
                                const f32x4 b2 = (f32x4){b[0] * c[2] - b[1] * s[2], b[1] * c[2] + b[0] * s[2], b[2] * c[3] - b[3] * s[3], b[3] * c[3] + b[2] * s[3]}; a = a2; b = b2; }
                    a = a * qscale; b = b * qscale;
                    u32x4 w; w.x = cvt_pk_bf16(a[0], a[1]); w.y = cvt_pk_bf16(a[2], a[3]); w.z = cvt_pk_bf16(b[0], b[1]); w.w = cvt_pk_bf16(b[2], b[3]);
                    const int col = (bj ? cb1 : cb0) + 8 * fq, hd = col / 96;
                    *(u32x4*)(O + ((size_t)((row >> 12) * 8 + hd) * 4096 + (row & 4095)) * 96 + (col - hd * 96)) = w; }
                asm volatile("" ::: "memory"); }
    }
};
struct EpiQkvDiff {
    static constexpr bool PERM = true, AFTER_DRAIN = false;
    bf16_t* O; const float* cosp; const float* sinp; float qscale; const float* SS; const float* bt;
    __device__ __forceinline__ void operator()(const f32x4 (&acc)[2][2][4][2], const Unit& u, int wr, int wc, int fr, int fq) const {
        const int row0 = u.pm * BM + wr * 64 + fr, col0 = u.pn * BM + wc * 32 + 8 * fq;
        const bool isq = u.pn < 4, ropew = (u.pn < 8) && ((wc & 1) == 0); const float sc = isq ? qscale : 1.0f; const bool ropel = fq < 2;
        const float* bp = bt + (size_t)((u.pm * BM) >> 12) * 3072 + col0;
        f32x4 bv[2][2];
#pragma unroll
        for (int bj = 0; bj < 2; ++bj)
#pragma unroll
            for (int n = 0; n < 2; ++n) bv[bj][n] = *(const f32x4*)(bp + bj * HALF + 4 * n);
#pragma unroll
        for (int ai = 0; ai < 2; ++ai)
#pragma unroll
            for (int m = 0; m < 4; ++m) { const int row = row0 + ai * HALF + m * 16;
                const float rstd = __builtin_amdgcn_rsqf(SS[row] * (1.0f / 1024.0f) + 1e-6f);
                f32x4 c = (f32x4){1.f, 1.f, 1.f, 1.f}, sn = (f32x4){0.f, 0.f, 0.f, 0.f};
                if (ropew) { c = *(const f32x4*)(cosp + (size_t)row * 8 + 4 * (fq & 1)); sn = *(const f32x4*)(sinp + (size_t)row * 8 + 4 * (fq & 1)); if (!ropel) { c = (f32x4){1.f, 1.f, 1.f, 1.f}; sn = (f32x4){0.f, 0.f, 0.f, 0.f}; } }
#pragma unroll
                for (int bj = 0; bj < 2; ++bj) { f32x4 a = acc[ai][bj][m][0] * rstd + bv[bj][0], b = acc[ai][bj][m][1] * rstd + bv[bj][1];
                    if (ropew) {
                        const f32x4 a2 = (f32x4){a[0] * c[0] - a[1] * sn[0], a[1] * c[0] + a[0] * sn[0], a[2] * c[1] - a[3] * sn[1], a[3] * c[1] + a[2] * sn[1]};
                        const f32x4 b2 = (f32x4){b[0] * c[2] - b[1] * sn[2], b[1] * c[2] + b[0] * sn[2], b[2] * c[3] - b[3] * sn[3], b[3] * c[3] + b[2] * sn[3]};
                        a = a2; b = b2; }
                    a = a * sc; b = b * sc;
                    u32x4 w; w.x = cvt_pk_bf16(a[0], a[1]); w.y = cvt_pk_bf16(a[2], a[3]); w.z = cvt_pk_bf16(b[0], b[1]); w.w = cvt_pk_bf16(b[2], b[3]);
                    const int col = col0 + bj * HALF, wi = col & 1023; const size_t bs = (size_t)(row >> 12), sq = (size_t)(row & 4095);
                    bf16_t* dst = (u.pn < 8) ? O + (size_t)(col >> 10) * 33554432 + ((bs * 16 + (wi >> 6)) * 4096 + sq) * 64 + (wi & 63)
                                             : O + (size_t)2 * 33554432 + ((bs * 8 + (wi >> 7)) * 4096 + sq) * 128 + (wi & 127);
                    *(u32x4*)dst = w; }
                asm volatile("" ::: "memory"); }
    }
};
}

#define LAS __attribute__((address_space(3)))
typedef unsigned short bf16_t;
typedef short bf16x8 __attribute__((ext_vector_type(8)));
typedef short s16x4 __attribute__((ext_vector_type(4)));
typedef float f32x4 __attribute__((ext_vector_type(4)));
typedef float f32x16 __attribute__((ext_vector_type(16)));
typedef unsigned u32x4 __attribute__((ext_vector_type(4)));
typedef unsigned u32x2 __attribute__((ext_vector_type(2)));
using pg8::cvt_pk_bf16;

constexpr int NB = 8, SEQ = 4096, T = NB * SEQ, D = 1024, DFF = 2816, INA = 1184, INA_P = 1280;
constexpr float EPS = 1e-6f;
constexpr float LOG2E = 1.4426950408889634f;
constexpr float LAMBDA_INIT = 0.35550907f;
constexpr size_t MiB = 1u << 20;
constexpr size_t WS_WIN = 0, WS_WUQ = 3 * MiB, WS_WUKV = 4 * MiB, WS_WPOOL = 5 * MiB, WS_WOA = 6 * MiB, WS_WOD = 8 * MiB, WS_WQKV = 10 * MiB,
                 WS_WGU0 = 16 * MiB, WS_WGU1 = 27 * MiB, WS_WD0 = 38 * MiB, WS_WD1 = 44 * MiB, WS_MOD = 50 * MiB, WS_COSR = 51 * MiB, WS_SINR = 53 * MiB,
                 WS_COSP = 55 * MiB, WS_SINP = 56 * MiB, WS_SMALL = 57 * MiB, WS_CTL = 58 * MiB;
constexpr int SM_N1G = 0, SM_N2G = 2048, SM_QNG = 4096, SM_KVNG = 4480, SM_POOLB = 4736, SM_POOLS = 5248, SM_LQ1 = 5760, SM_LK1 = 5824, SM_LQ2 = 5888, SM_LK2 = 5952, SM_SUBLN = 6016, SM_FNG = 6144, SM_TOTAL = 7168;
constexpr size_t WS_A = 64 * MiB;
constexpr size_t WS_PROJ = WS_A, WS_CQN = WS_A + 80 * MiB, WS_CKVN = WS_A + 104 * MiB, WS_KR = WS_A + 120 * MiB, WS_POOLED = WS_A + 122 * MiB, WS_KV = WS_A + 154 * MiB;
constexpr size_t WS_QM = WS_A, WS_H = WS_A, WS_QKV = WS_A;
constexpr size_t WS_STASH = 282 * MiB;
constexpr size_t WS_XN = 314 * MiB;
constexpr size_t WS_XR = 378 * MiB;
constexpr size_t WS_XA = 240 * MiB;
constexpr size_t WS_END = 506 * MiB;
constexpr size_t WS_ATAB = 59 * MiB, WS_BT = WS_ATAB + 128 * 1024, WS_SS = 60 * MiB;
constexpr int BT_GU0 = 0, BT_QKV = 8 * 5632, BT_GU1 = 8 * 5632 + 8 * 3072;

struct Params {
    const float *x, *c; const int* pos;
    const float *ada_w, *ada_b, *n1g, *n2g, *wgu, *wd, *w_in, *qng, *kvng, *wuq, *wukv, *pool_w, *pool_b, *pool_s, *wouta, *wqkv, *lq1, *lk1, *lq2, *lk2, *subln, *woutd, *fng;
    float* out; unsigned char* ws;
};

__device__ __forceinline__ int opq_tid() { int t = threadIdx.x; asm volatile("" : "+v"(t)); return t; }
__device__ __forceinline__ float wave_sum(float v) {
#pragma unroll
    for (int o = 1; o < 64; o <<= 1) v += __shfl_xor(v, o);
    return v;
}
__device__ __forceinline__ unsigned f2bf(float f) { unsigned u = __builtin_bit_cast(unsigned, f); return (u + 0x7fffu + ((u >> 16) & 1u)) >> 16; }
typedef float pkf32x2_t __attribute__((ext_vector_type(2))); typedef __bf16 pkbf16x2_t __attribute__((ext_vector_type(2)));
__device__ __forceinline__ unsigned pk2(float lo, float hi) { pkf32x2_t v = {lo, hi}; pkbf16x2_t b = __builtin_convertvector(v, pkbf16x2_t); return __builtin_bit_cast(unsigned, b); }
__device__ __forceinline__ float bf2f(unsigned short h) { return __builtin_bit_cast(float, (unsigned)h << 16); }
__device__ __forceinline__ float bflo(unsigned w) { return __builtin_bit_cast(float, w << 16); }
__device__ __forceinline__ float bfhi(unsigned w) { return __builtin_bit_cast(float, w & 0xffff0000u); }

__device__ __forceinline__ void tr_item(const float* W, int K, int N, bf16_t* WT, int ldd, int coloff, int roff, int mode, LAS float* scr, int item, int lane) {
    const int nblk = N / 32, kb = item / nblk, nb = item % nblk, k0 = 64 * kb, n0 = 32 * nb;
#pragma unroll 8
    for (int i = 0; i < 32; ++i) { const int kk = 2 * i + (lane >> 5); scr[kk * 33 + (lane & 31)] = W[(size_t)(k0 + kk) * N + n0 + (lane & 31)]; }
    asm volatile("s_waitcnt lgkmcnt(0)" ::: "memory");
    const int c = lane & 7;
#pragma unroll
    for (int j = 0; j < 4; ++j) { const int n = (lane >> 3) + 8 * j; const LAS float* s = scr + (8 * c) * 33 + n;
        u32x4 o; o.x = pk2(s[0 * 33], s[1 * 33]); o.y = pk2(s[2 * 33], s[3 * 33]); o.z = pk2(s[4 * 33], s[5 * 33]); o.w = pk2(s[6 * 33], s[7 * 33]);
        const int ng = n0 + n; int dr;
        if (mode == 1) { const int jj = (ng < DFF) ? ng : ng - DFF; dr = (jj >> 7) * 256 + (jj & 127) + ((ng < DFF) ? 0 : 128); }
        else if (mode == 2) { const int loc = ng & 63; dr = (ng < 2048 && loc < 16) ? (ng - loc) + ((loc & 7) >> 2) * 8 + (loc & 3) * 2 + (loc >> 3) : ng; }
        else if (mode == 3) { const int loc = ng % 96; dr = (loc >= 64) ? (ng - loc) + 64 + ((loc - 64 < 16) ? 2 * (loc - 64) : 2 * (loc - 80) + 1) : ng; }
        else dr = ng + roff;
        *(u32x4*)(WT + (size_t)dr * ldd + coloff + k0 + 8 * c) = o; }
    asm volatile("s_waitcnt lgkmcnt(0)" ::: "memory");
}

__device__ __forceinline__ void norm_pass(const float* src, const float* g, const float* mod, int sh_off, int sc_off, bf16_t* dst, int vcu, int G) {
    const int tid_ = opq_tid(), lane = tid_ & 63, gw = vcu * 8 + __builtin_amdgcn_readfirstlane(tid_ >> 6), ngw = G * 8;
    for (int row = gw; row < T; row += ngw) {
        const f32x4* xr = (const f32x4*)(src + (size_t)row * D) + lane;
        f32x4 v[4]; float s = 0.f;
#pragma unroll
        for (int j = 0; j < 4; ++j) { v[j] = xr[64 * j]; s += (v[j].x * v[j].x + v[j].y * v[j].y) + (v[j].z * v[j].z + v[j].w * v[j].w); }
        const float rstd = 1.0f / sqrtf(wave_sum(s) * (1.0f / D) + EPS);
        const float* mb = mod + (size_t)(row >> 12) * 6144;
        u32x2* o8 = (u32x2*)(dst + (size_t)row * D) + lane;
#pragma unroll
        for (int j = 0; j < 4; ++j) { const int col = 4 * lane + 256 * j;
            const f32x4 gg = *(const f32x4*)(g + col), sc = *(const f32x4*)(mb + sc_off + col), sh = *(const f32x4*)(mb + sh_off + col);
            const f32x4 y = v[j] * rstd * gg * (sc + 1.0f) + sh;
            u32x2 w; w.x = pk2(y.x, y.y); w.y = pk2(y.z, y.w); o8[64 * j] = w; }
    }
}
__device__ __forceinline__ void final_norm(const float* src, const float* g, float* dst, int vcu, int G) {
    const int tid_ = opq_tid(), lane = tid_ & 63, gw = vcu * 8 + __builtin_amdgcn_readfirstlane(tid_ >> 6), ngw = G * 8;
    for (int row = gw; row < T; row += ngw) {
        const f32x4* xr = (const f32x4*)(src + (size_t)row * D) + lane;
        f32x4 v[4]; float s = 0.f;
#pragma unroll
        for (int j = 0; j < 4; ++j) { v[j] = xr[64 * j]; s += (v[j].x * v[j].x + v[j].y * v[j].y) + (v[j].z * v[j].z + v[j].w * v[j].w); }
        const float rstd = 1.0f / sqrtf(wave_sum(s) * (1.0f / D) + EPS);
        f32x4* o = (f32x4*)(dst + (size_t)row * D) + lane;
#pragma unroll
        for (int j = 0; j < 4; ++j) { const f32x4 gg = *(const f32x4*)(g + 4 * lane + 256 * j); o[64 * j] = v[j] * rstd * gg; }
    }
}

__device__ __forceinline__ void mid_pass(const bf16_t* PROJ, const float* qng, const float* kvng, const float* cosr, const float* sinr,
                                         bf16_t* CQN, bf16_t* CKVN, bf16_t* KR, bf16_t* POOLED, int vcu, int G) {
    const int tid_ = opq_tid(), lane = tid_ & 63, gw = vcu * 8 + __builtin_amdgcn_readfirstlane(tid_ >> 6), ngw = G * 8;
    for (int row = gw; row < T; row += ngw) {
        const bf16_t* pr = PROJ + (size_t)row * INA_P; const int s = row & (SEQ - 1);
        {
            float a[3][2]; float ss = 0.f;
#pragma unroll
            for (int j = 0; j < 3; ++j) { const unsigned w = *(const unsigned*)(pr + 128 * j + 2 * lane); a[j][0] = bflo(w); a[j][1] = bfhi(w); ss += a[j][0] * a[j][0] + a[j][1] * a[j][1]; }
            const float rstd = 1.0f / sqrtf(wave_sum(ss) * (1.0f / 384.0f) + EPS);
#pragma unroll
            for (int j = 0; j < 3; ++j) { const int col = 128 * j + 2 * lane; *(unsigned*)(CQN + (size_t)row * 384 + col) = pk2(a[j][0] * rstd * qng[col], a[j][1] * rstd * qng[col + 1]); }
        }
        {
            const u32x2 w = *(const u32x2*)(pr + 384 + 4 * lane); const float a0 = bflo(w.x), a1 = bfhi(w.x), a2 = bflo(w.y), a3 = bfhi(w.y);
            const float rstd = 1.0f / sqrtf(wave_sum(a0 * a0 + a1 * a1 + a2 * a2 + a3 * a3) * (1.0f / 256.0f) + EPS);
            const f32x4 gg = *(const f32x4*)(kvng + 4 * lane);
            u32x2 o; o.x = pk2(a0 * rstd * gg.x, a1 * rstd * gg.y); o.y = pk2(a2 * rstd * gg.z, a3 * rstd * gg.w);
            *(u32x2*)(CKVN + (size_t)row * 256 + 4 * lane) = o;
        }
        if (lane < 16) {
            const float x1 = bf2f(pr[640 + lane]), x2 = bf2f(pr[656 + lane]), c = cosr[(size_t)row * 16 + lane], sn = sinr[(size_t)row * 16 + lane];
            *(unsigned*)(KR + (size_t)row * 32 + 2 * lane) = pk2(x1 * c - x2 * sn, x2 * c + x1 * sn);
        }
        {
            const int win = 2 << (lane >> 4); const bf16_t* up = pr + 672 + 8 * lane;
            const u32x4 cw = *(const u32x4*)up;
            float cur[8] = {bflo(cw.x), bfhi(cw.x), bflo(cw.y), bfhi(cw.y), bflo(cw.z), bfhi(cw.z), bflo(cw.w), bfhi(cw.w)};
            float sum[8];
#pragma unroll
            for (int e = 0; e < 8; ++e) sum[e] = cur[e];
            u32x4 pw[15];
#pragma unroll
            for (int w = 1; w < 16; ++w) { const int back = (w <= s) ? w : s; pw[w - 1] = *(const u32x4*)(up - (size_t)back * INA_P); }
#pragma unroll
            for (int w = 1; w < 16; ++w) { const float k = (w < win && w <= s) ? 1.0f : 0.0f; const u32x4 q = pw[w - 1];
                sum[0] += k * bflo(q.x); sum[1] += k * bfhi(q.x); sum[2] += k * bflo(q.y); sum[3] += k * bfhi(q.y); sum[4] += k * bflo(q.z); sum[5] += k * bfhi(q.z); sum[6] += k * bflo(q.w); sum[7] += k * bfhi(q.w); }
            const float ic = 1.0f / (float)((s + 1 < win) ? s + 1 : win);
            u32x4 o; o.x = pk2(sum[0] * ic - cur[0], sum[1] * ic - cur[1]); o.y = pk2(sum[2] * ic - cur[2], sum[3] * ic - cur[3]);
            o.z = pk2(sum[4] * ic - cur[4], sum[5] * ic - cur[5]); o.w = pk2(sum[6] * ic - cur[6], sum[7] * ic - cur[7]);
            *(u32x4*)(POOLED + (size_t)row * 512 + 8 * lane) = o;
        }
    }
}

typedef float f32x2_t __attribute__((ext_vector_type(2))); typedef __bf16 bf16x2_t __attribute__((ext_vector_type(2)));
__device__ __forceinline__ unsigned cvtpk_s(float lo, float hi) { f32x2_t v = {lo, hi}; bf16x2_t b = __builtin_convertvector(v, bf16x2_t); return __builtin_bit_cast(unsigned, b); }
#define MAX3F(a, b, c) __builtin_fmaxf(__builtin_fmaxf((a), (b)), (c))
constexpr float RESC_THR = 6.0f;
#define MFMA32(a, b, c) __builtin_amdgcn_mfma_f32_32x32x16_bf16((a), (b), (c), 0, 0, 0)
typedef short v4i16_t __attribute__((ext_vector_type(4)));
__device__ __forceinline__ s16x4 vtr(LAS const unsigned char* p) { return __builtin_bit_cast(s16x4, __builtin_amdgcn_ds_read_tr16_b64_v4i16((LAS v4i16_t*)p)); }

template <int DQK, int DV> struct AttnCfg {
    static constexpr int KP = DQK * 2 + 16, VP = DV * 2 + 64, KBYTES = 64 * KP, VBYTES = 64 * VP, OP = DV * 2 + 16;
    static constexpr int VOFF = 4 * KBYTES, OST = 0, RINGS = 4 * KBYTES + 4 * VBYTES, TOTAL = RINGS > 8 * 32 * OP ? RINGS : 8 * 32 * OP;
};
template <int ND, int KP>
__device__ __forceinline__ void qk_tile(LAS const unsigned char* kb, const bf16x8 (&qr)[ND], const f32x16& cinit, f32x16& p0, f32x16& p1) {
#pragma unroll
    for (int d0 = 0; d0 < ND; ++d0) {
        const bf16x8 a0 = *(LAS const bf16x8*)(kb + 32 * d0), a1 = *(LAS const bf16x8*)(kb + 32 * KP + 32 * d0);
        if (d0 == 0) { p0 = MFMA32(a0, qr[0], cinit); p1 = MFMA32(a1, qr[0], cinit); }
        else { p0 = MFMA32(a0, qr[d0], p0); p1 = MFMA32(a1, qr[d0], p1); }
    }
}
template <int DQK, int DKA, int DV>
__device__ __forceinline__ void attn_qblock(const bf16_t* __restrict__ Qp, int ldq, const bf16_t* __restrict__ KAp, int ldka, const bf16_t* __restrict__ KBp, int ldkb,
                                            const bf16_t* __restrict__ Vp, int ldv, int q0, LAS unsigned char* lds, f32x16 (&o)[DV / 32]) {
    typedef AttnCfg<DQK, DV> C;
    constexpr int KP = C::KP, VP = C::VP, ND = DQK / 16, NV = DV / 32, KCH = DQK / 8, NKC = 64 * KCH, KPT = (NKC + 511) / 512, VCH = DV / 8, NVC = 64 * VCH, VPT = NVC / 512;
    constexpr bool NEGM = true;
    const int tid = opq_tid(), lane = tid & 63, r32 = lane & 31, hi = lane >> 5, wid = __builtin_amdgcn_readfirstlane(tid >> 6);
    bf16x8 qr[ND];
    { const bf16_t* qrow = Qp + (size_t)(q0 + 32 * wid + r32) * ldq + 8 * hi;
#pragma unroll
      for (int d0 = 0; d0 < ND; ++d0) qr[d0] = *(const bf16x8*)(qrow + 16 * d0); }
    const int NT = (q0 + 256) / 64;
    static_assert(DKA == 64 && (DQK == 64 || DQK == 96), "staging map");
    constexpr bool HASB = (DQK > DKA);
    u32x4 kst[KPT], vst[VPT];
    const unsigned offA = (unsigned)((tid >> 3) * ldka + (tid & 7) * 8) * 2u, ldsA = (unsigned)((tid >> 3) * KP + (tid & 7) * 16);
    const unsigned offB = (unsigned)((tid >> 2) * ldkb + (tid & 3) * 8) * 2u, ldsB = (unsigned)((tid >> 2) * KP + DKA * 2 + (tid & 3) * 16);
    const unsigned offV = (unsigned)((tid / VCH) * ldv + (tid % VCH) * 8) * 2u, ldsV = (unsigned)((tid / VCH) * VP + (tid % VCH) * 16);
#define ATT_LOADK_R(R, t) do { R[0] = *(const u32x4*)((const char*)KAp + (size_t)(t) * (size_t)(128 * ldka) + offA); \
    if (HASB) { if (tid < 256) R[KPT - 1] = *(const u32x4*)((const char*)KBp + (size_t)(t) * (size_t)(128 * ldkb) + offB); } } while (0)
#define ATT_LOADK(t) ATT_LOADK_R(kst, t)
#define ATT_LOADV_R(R, t) do { _Pragma("unroll") for (int i = 0; i < VPT; ++i) R[i] = *(const u32x4*)((const char*)Vp + ((size_t)(t) * 64 + (size_t)i * (512 / VCH)) * (size_t)(2 * ldv) + offV); } while (0)
#define ATT_LOADV(t) ATT_LOADV_R(vst, t)
#define ATT_STOREK_R(R, sl) do { *(LAS u32x4*)(lds + (sl) * C::KBYTES + ldsA) = R[0]; \
    if (HASB) { if (tid < 256) *(LAS u32x4*)(lds + (sl) * C::KBYTES + ldsB) = R[KPT - 1]; } } while (0)
#define ATT_STOREK(sl) ATT_STOREK_R(kst, sl)
#define ATT_STOREV_R(R, sl) do { _Pragma("unroll") for (int i = 0; i < VPT; ++i) *(LAS u32x4*)(lds + C::VOFF + (sl) * C::VBYTES + i * (512 / VCH) * VP + ldsV) = R[i]; } while (0)
#define ATT_STOREV(sl) ATT_STOREV_R(vst, sl)
    __syncthreads();
    { u32x4 ka[KPT], kb[KPT], kc[KPT], va[VPT], vb_[VPT];
      ATT_LOADK_R(ka, 0); ATT_LOADV_R(va, 0); ATT_LOADK_R(kb, 1); ATT_LOADV_R(vb_, 1); ATT_LOADK_R(kc, 2);
      ATT_LOADK(3); ATT_LOADV(2);
      ATT_STOREK_R(ka, 0); ATT_STOREV_R(va, 0); ATT_STOREK_R(kb, 1); ATT_STOREV_R(vb_, 1); ATT_STOREK_R(kc, 2); }
    __syncthreads();
    float m = 0.f, l = 0.f; f32x16 negm;
#pragma unroll
    for (int i = 0; i < 16; ++i) negm[i] = 0.f;
#pragma unroll
    for (int v = 0; v < NV; ++v)
#pragma unroll
        for (int i = 0; i < 16; ++i) o[v][i] = 0.f;
    const int qabs = q0 + 32 * wid + r32, qlast = q0 + 32 * wid + 31;
    const int koff = r32 * KP + hi * 16;
    const int voff = (4 * hi + ((lane & 15) >> 2)) * VP + (16 * ((lane >> 4) & 1) + 4 * (lane & 3)) * 2;
    bf16x8 kf[2 * ND];
#define ATT_KFRAG(slot) do { LAS const unsigned char* kb_ = lds + (slot) * C::KBYTES + koff; \
    _Pragma("unroll") for (int d0 = 0; d0 < ND; ++d0) { kf[2 * d0] = *(LAS const bf16x8*)(kb_ + 32 * d0); kf[2 * d0 + 1] = *(LAS const bf16x8*)(kb_ + 32 * KP + 32 * d0); } } while (0)
#define ATT_VFRAG(vv) do { _Pragma("unroll") for (int j = 0; j < 2; ++j) _Pragma("unroll") for (int s4 = 0; s4 < 4; ++s4) { \
        vlo[j * 4 + s4] = vtr(vb + (16 * s4) * VP + 64 * ((vv) + j)); vhi[j * 4 + s4] = vtr(vb + (16 * s4 + 8) * VP + 64 * ((vv) + j)); } } while (0)
#define ATT_PV(vv) do { _Pragma("unroll") for (int s4 = 0; s4 < 4; ++s4) _Pragma("unroll") for (int j = 0; j < 2; ++j) { \
        const bf16x8 vf = __builtin_shufflevector(vlo[j * 4 + s4], vhi[j * 4 + s4], 0, 1, 2, 3, 4, 5, 6, 7); o[(vv) + j] = MFMA32(vf, pf[s4], o[(vv) + j]); } } while (0)
    ATT_KFRAG(0);
    for (int t = 0; t < NT; ++t) {
        const int ks1 = (t + 1) & 3;
        if (t + 3 < NT) ATT_STOREK((t + 3) & 3);
        if (t + 2 < NT) ATT_STOREV((t + 2) & 3);
        if (t + 4 < NT) ATT_LOADK(t + 4);
        if (t + 3 < NT) ATT_LOADV(t + 3);
        if (64 * t <= qlast) {
            f32x16 p0, p1; s16x4 vlo[8], vhi[8]; bf16x8 pf[4];
            LAS const unsigned char* vb = lds + C::VOFF + (t & 3) * C::VBYTES + voff;
            __builtin_amdgcn_sched_barrier(0);
            __builtin_amdgcn_s_setprio(1);
#pragma unroll
            for (int d0 = 0; d0 < ND; ++d0) {
                if (d0 == 0) { p0 = MFMA32(kf[0], qr[0], negm); p1 = MFMA32(kf[1], qr[0], negm); }
                else { p0 = MFMA32(kf[2 * d0], qr[d0], p0); p1 = MFMA32(kf[2 * d0 + 1], qr[d0], p1); }
            }
            __builtin_amdgcn_s_setprio(0);
            __builtin_amdgcn_sched_barrier(0);
            ATT_VFRAG(0);
            __builtin_amdgcn_sched_barrier(0);
            if (64 * t + 63 > q0 + 32 * wid) {
                const int kvb = 64 * t + 4 * hi;
#pragma unroll
                for (int i = 0; i < 16; ++i) { const int kv = kvb + (i & 3) + 8 * (i >> 2); if (kv > qabs) p0[i] = -INFINITY; if (kv + 32 > qabs) p1[i] = -INFINITY; }
            }
            float mxa = MAX3F(p0[0], p0[1], p1[0]), mxb = MAX3F(p0[2], p0[3], p1[1]); mxa = MAX3F(mxa, p1[2], p1[3]);
#pragma unroll
            for (int i = 4; i < 16; i += 4) { mxa = MAX3F(mxa, p0[i], p0[i + 1]); mxb = MAX3F(mxb, p0[i + 2], p0[i + 3]); mxa = MAX3F(mxa, p1[i], p1[i + 1]); mxb = MAX3F(mxb, p1[i + 2], p1[i + 3]); }
            float mx = fmaxf(mxa, mxb);
            { auto rr = __builtin_amdgcn_permlane32_swap(__float_as_uint(mx), __float_as_uint(mx), false, false); mx = fmaxf(__uint_as_float(rr[0]), __uint_as_float(rr[1])); }
            if (!NEGM) mx -= m;
            if (t == 0) {
                m = mx;
                if (NEGM) {
#pragma unroll
                    for (int i = 0; i < 16; ++i) { p0[i] -= mx; p1[i] -= mx; }
#pragma unroll
                    for (int i = 0; i < 16; ++i) negm[i] = -m;
                }
            } else if (__any(mx > RESC_THR)) {
                const float dl = fmaxf(mx, 0.f), alpha = __builtin_amdgcn_exp2f(-dl); m += dl;
                if (NEGM) {
#pragma unroll
                    for (int i = 0; i < 16; ++i) { p0[i] -= dl; p1[i] -= dl; }
#pragma unroll
                    for (int i = 0; i < 16; ++i) negm[i] = -m;
                }
                l *= alpha;
#pragma unroll
                for (int v = 0; v < NV; ++v)
#pragma unroll
                    for (int i = 0; i < 16; ++i) o[v][i] *= alpha;
            }
            { float rs = 0.f;
#pragma unroll
              for (int i = 0; i < 16; ++i) { p0[i] = __builtin_amdgcn_exp2f(NEGM ? p0[i] : p0[i] - m); p1[i] = __builtin_amdgcn_exp2f(NEGM ? p1[i] : p1[i] - m); rs += p0[i] + p1[i]; }
              l += rs;
#pragma unroll
              for (int s = 0; s < 2; ++s) { u32x4 w0, w1;
                w0.x = cvtpk_s(p0[8 * s], p0[8 * s + 1]); w0.y = cvtpk_s(p0[8 * s + 2], p0[8 * s + 3]); w0.z = cvtpk_s(p0[8 * s + 4], p0[8 * s + 5]); w0.w = cvtpk_s(p0[8 * s + 6], p0[8 * s + 7]);
                w1.x = cvtpk_s(p1[8 * s], p1[8 * s + 1]); w1.y = cvtpk_s(p1[8 * s + 2], p1[8 * s + 3]); w1.z = cvtpk_s(p1[8 * s + 4], p1[8 * s + 5]); w1.w = cvtpk_s(p1[8 * s + 6], p1[8 * s + 7]);
                pf[s] = __builtin_bit_cast(bf16x8, w0); pf[2 + s] = __builtin_bit_cast(bf16x8, w1); } }
            __builtin_amdgcn_sched_barrier(0);
            if (NV == 2) {
                __builtin_amdgcn_s_setprio(1); ATT_PV(0); __builtin_amdgcn_s_setprio(0);
                __builtin_amdgcn_sched_barrier(0);
                if (t + 1 < NT) ATT_KFRAG(ks1);
            } else {
                __builtin_amdgcn_s_setprio(1); ATT_PV(0); __builtin_amdgcn_s_setprio(0);
                __builtin_amdgcn_sched_barrier(0);
                ATT_VFRAG(2);
                __builtin_amdgcn_sched_barrier(0);
                __builtin_amdgcn_s_setprio(1); ATT_PV(2); __builtin_amdgcn_s_setprio(0);
                __builtin_amdgcn_sched_barrier(0);
                if (t + 1 < NT) ATT_KFRAG(ks1);
            }
            __builtin_amdgcn_sched_barrier(0);
        }
        if (t & 1) asm volatile("s_waitcnt lgkmcnt(0)\n\ts_barrier" ::: "memory");
    }
#undef ATT_KFRAG
#undef ATT_VFRAG
#undef ATT_PV
#undef ATT_LOADK
#undef ATT_LOADK_R
#undef ATT_LOADV_R
#undef ATT_STOREK_R
#undef ATT_STOREV_R
#undef ATT_LOADV
#undef ATT_STOREK
#undef ATT_STOREV
    l += __shfl_xor(l, 32);
    const float il = 1.0f / l;
#pragma unroll
    for (int v = 0; v < NV; ++v)
#pragma unroll
        for (int i = 0; i < 16; ++i) o[v][i] *= il;
}
template <int DQK, int DV>
__device__ __forceinline__ void attn_store(const f32x16 (&o)[DV / 32], bf16_t* dst, int ldo, LAS unsigned char* lds) {
    typedef AttnCfg<DQK, DV> C; constexpr int OP = C::OP, NV = DV / 32;
    const int tid = opq_tid(), lane = tid & 63, r32 = lane & 31, hi = lane >> 5, wid = __builtin_amdgcn_readfirstlane(tid >> 6);
    LAS unsigned char* ost = lds + C::OST + wid * (32 * OP);
#pragma unroll
    for (int v = 0; v < NV; ++v)
#pragma unroll
        for (int g = 0; g < 4; ++g) { u32x2 w; w.x = cvt_pk_bf16(o[v][4 * g], o[v][4 * g + 1]); w.y = cvt_pk_bf16(o[v][4 * g + 2], o[v][4 * g + 3]);
            *(LAS u32x2*)(ost + r32 * OP + (32 * v + 8 * g + 4 * hi) * 2) = w; }
    asm volatile("s_waitcnt lgkmcnt(0)" ::: "memory");
#pragma unroll
    for (int k = 0; k < DV / 16; ++k) { const int c = lane + 64 * k, row = c / (DV / 8), ch = c % (DV / 8);
        const u32x4 v = *(LAS const u32x4*)(ost + row * OP + ch * 16); *(u32x4*)(dst + (size_t)(32 * wid + row) * ldo + ch * 8) = v; }
    asm volatile("s_waitcnt lgkmcnt(0)" ::: "memory");
}

#define XB_TMO      128
#define XB_XCNT(j)  (256  + 64 * (j))
#define XB_XSUB(j)  (1280 + 64 * (j))
#define XB_XGEN(j)  (2304 + 64 * (j))
#define XB_TOP      3328
#define XB_TOPGEN   3392
#define XCD_BAR_WORDS 3456
#define XB_SPIN_CAP (1u << 18)

__device__ __forceinline__ unsigned xb_ld(unsigned* p)              { return __hip_atomic_load(p, __ATOMIC_RELAXED, __HIP_MEMORY_SCOPE_AGENT); }
__device__ __forceinline__ unsigned xb_add(unsigned* p, unsigned v) { return __hip_atomic_fetch_add(p, v, __ATOMIC_RELAXED, __HIP_MEMORY_SCOPE_AGENT); }
__device__ __forceinline__ unsigned xb_xcc_id() { return (unsigned)__builtin_amdgcn_s_getreg((3 << 11) | 20) & 0xFu; }
#define XB_SPIN(cond, bar) do { unsigned _sp = 0; while (cond) { __builtin_amdgcn_s_sleep(1); \
    if ((++_sp & 255u) == 0u) { if (xb_ld(&(bar)[XB_TMO])) break; if (_sp > XB_SPIN_CAP) { atomicAdd(&(bar)[XB_TMO], 1u); break; } } } } while (0)

struct XcdBarrier {
    unsigned* bar; unsigned x;
    volatile LAS unsigned* st;
};

__device__ __forceinline__ XcdBarrier xcd_barrier_post(unsigned* bar, volatile LAS unsigned* st) {
    XcdBarrier b; b.bar = bar; b.x = xb_xcc_id(); b.st = st;
    if (threadIdx.x == 0) (void)xb_add(&bar[XB_XCNT(b.x)], 1u);
    return b;
}
__device__ __forceinline__ void xcd_barrier_complete(unsigned* bar, unsigned x, unsigned& nloc, unsigned& nx) {
    const unsigned G = gridDim.x * gridDim.y * gridDim.z;
    unsigned sum, cnt, mine, sp = 0u;
    for (;;) {
        sum = 0u; cnt = 0u; mine = 0u;
#pragma unroll
        for (unsigned j = 0; j < 16; ++j) { const unsigned c = xb_ld(&bar[XB_XCNT(j)]); sum += c; cnt += (c > 0u) ? 1u : 0u; mine = (j == x) ? c : mine; }
        if (sum == G) break;
        __builtin_amdgcn_s_sleep(1);
        if ((++sp & 255u) == 0u) { if (xb_ld(&bar[XB_TMO])) break; if (sp > XB_SPIN_CAP) { atomicAdd(&bar[XB_TMO], 1u); break; } }
    }
    nloc = mine > 0u ? mine : 1u; nx = cnt > 0u ? cnt : 1u;
}

__device__ __forceinline__ void xcd_barrier(const XcdBarrier& b) {
    asm volatile("s_waitcnt vmcnt(0)" ::: "memory");
    __syncthreads();
    if (threadIdx.x == 0) {
        unsigned* bar = b.bar;
        __builtin_amdgcn_s_waitcnt(0);
        unsigned nloc = b.st[0], nx = b.st[1];
        if (nloc == 0u) { xcd_barrier_complete(bar, b.x, nloc, nx); b.st[0] = nloc; b.st[1] = nx; }
        const unsigned old = xb_add(&bar[XB_XSUB(b.x)], 1u);
        const unsigned gen = old / nloc;
        if (old + 1u == (gen + 1u) * nloc) {
            __builtin_amdgcn_fence(__ATOMIC_RELEASE, "agent");
            asm volatile("s_waitcnt vmcnt(0)" ::: "memory");
            const unsigned og = xb_add(&bar[XB_TOP], 1u);
            const unsigned tg = og / nx;
            if (og + 1u == (tg + 1u) * nx) xb_add(&bar[XB_TOPGEN], 1u);
            else XB_SPIN(xb_ld(&bar[XB_TOPGEN]) == tg, bar);
            __builtin_amdgcn_fence(__ATOMIC_ACQUIRE, "agent");
            xb_add(&bar[XB_XGEN(b.x)], 1u);
            asm volatile("s_waitcnt vmcnt(0)" ::: "memory");
        } else {
            XB_SPIN(xb_ld(&bar[XB_XGEN(b.x)]) == gen, bar);
            __builtin_amdgcn_fence(__ATOMIC_ACQUIRE, "agent");
            asm volatile("s_waitcnt vmcnt(0)" ::: "memory");
        }
    }
    __syncthreads();
}

constexpr int LDS_BYTES = 147456;
static_assert(AttnCfg<96, 64>::TOTAL <= LDS_BYTES - 64 && AttnCfg<64, 128>::TOTAL <= LDS_BYTES - 64, "attention LDS");

__global__ void __launch_bounds__(512, 2) fwd_megakernel(Params p) {
    extern __shared__ __attribute__((aligned(16))) unsigned char lds_raw[];
    LAS unsigned char* lds = (LAS unsigned char*)lds_raw;
    cg::grid_group grid = cg::this_grid();
    const int G = gridDim.x, bx = blockIdx.x;
    const int vcu = (G % 8 == 0) ? (bx % 8) * (G / 8) + bx / 8 : bx;
    unsigned char* ws = p.ws;
    unsigned* BARW = (unsigned*)(ws + WS_CTL);
    volatile LAS unsigned* bst = (volatile LAS unsigned*)(lds + LDS_BYTES - 64);
    if (threadIdx.x < 2) bst[threadIdx.x] = 0u;
    if (bx == 0) for (int i = threadIdx.x; i < XCD_BAR_WORDS; i += 512) BARW[i] = 0u;
    __syncthreads();
    bf16_t* WIN = (bf16_t*)(ws + WS_WIN); bf16_t* WUQ = (bf16_t*)(ws + WS_WUQ); bf16_t* WUKV = (bf16_t*)(ws + WS_WUKV); bf16_t* WPOOL = (bf16_t*)(ws + WS_WPOOL);
    bf16_t* WOA = (bf16_t*)(ws + WS_WOA); bf16_t* WOD = (bf16_t*)(ws + WS_WOD); bf16_t* WQKV = (bf16_t*)(ws + WS_WQKV);
    bf16_t* WGU0 = (bf16_t*)(ws + WS_WGU0); bf16_t* WGU1 = (bf16_t*)(ws + WS_WGU1); bf16_t* WD0 = (bf16_t*)(ws + WS_WD0); bf16_t* WD1 = (bf16_t*)(ws + WS_WD1);
    float* MOD = (float*)(ws + WS_MOD); float* COSR = (float*)(ws + WS_COSR); float* SINR = (float*)(ws + WS_SINR); float* COSP = (float*)(ws + WS_COSP); float* SINP = (float*)(ws + WS_SINP);
    bf16_t* PROJ = (bf16_t*)(ws + WS_PROJ); bf16_t* CQN = (bf16_t*)(ws + WS_CQN); bf16_t* CKVN = (bf16_t*)(ws + WS_CKVN); bf16_t* KR = (bf16_t*)(ws + WS_KR);
    bf16_t* POOLED = (bf16_t*)(ws + WS_POOLED); bf16_t* KV = (bf16_t*)(ws + WS_KV); bf16_t* QM = (bf16_t*)(ws + WS_QM); bf16_t* HB = (bf16_t*)(ws + WS_H); bf16_t* QKV = (bf16_t*)(ws + WS_QKV);
    bf16_t* XN = (bf16_t*)(ws + WS_XN); float* XR = (float*)(ws + WS_XR); float* STASH = (float*)(ws + WS_STASH); float* SM = (float*)(ws + WS_SMALL);
    bf16_t* XA = (bf16_t*)(ws + WS_XA); float* ATAB = (float*)(ws + WS_ATAB); float* BT = (float*)(ws + WS_BT); float* SS = (float*)(ws + WS_SS);

    {
        const int tid = opq_tid(), lane = tid & 63, wave = __builtin_amdgcn_readfirstlane(tid >> 6), gw = vcu * 8 + wave, ngw = G * 8;
        LAS float* sc = (LAS float*)lds;
        LAS float* red = (LAS float*)(lds + 32768);
        for (int i = tid; i < NB * D; i += 512) { const float v = p.c[i]; sc[i] = v / (1.0f + __expf(-v)); }
        __syncthreads();
        for (int item = vcu; item < 192; item += G) {
            const int l = item / 96, col = (item % 96) * 64 + lane;
            const float* w = p.ada_w + (size_t)l * D * 6144 + col;
            float acc[8] = {0.f, 0.f, 0.f, 0.f, 0.f, 0.f, 0.f, 0.f};
            const int k0 = wave * 128;
#pragma unroll 8
            for (int k = 0; k < 128; ++k) { const float wv = w[(size_t)(k0 + k) * 6144];
#pragma unroll
                for (int b = 0; b < 8; ++b) acc[b] += sc[b * D + k0 + k] * wv; }
#pragma unroll
            for (int b = 0; b < 8; ++b) red[(wave * 8 + b) * 64 + lane] = acc[b];
            __syncthreads();
            { float s = 0.f;
#pragma unroll
              for (int w8 = 0; w8 < 8; ++w8) s += red[(w8 * 8 + wave) * 64 + lane];
              MOD[(size_t)(l * 8 + wave) * 6144 + col] = s + p.ada_b[l * 6144 + col]; }
            __syncthreads();
        }
        __syncthreads();
        LAS float* scr = (LAS float*)(lds + wave * 16384);
        constexpr int I_IN = 16 * 37, I_UQ = 6 * 24, I_UKV = 4 * 32, I_POOL = 2 * 4, I_O = 16 * 32, I_QKV = 16 * 96, I_GU = 16 * 176, I_D = 44 * 32;
        constexpr int NITEMS = I_IN + I_UQ + I_UKV + 4 * I_POOL + 2 * I_O + I_QKV + 2 * I_GU + 2 * I_D;
        for (int it = gw; it < NITEMS; it += ngw) {
            int r = it;
            if (r < I_IN) { tr_item(p.w_in, D, INA, WIN, D, 0, 0, 0, scr, r, lane); continue; } r -= I_IN;
            if (r < I_UQ) { tr_item(p.wuq, 384, 768, WUQ, 384, 0, 0, 3, scr, r, lane); continue; } r -= I_UQ;
            if (r < I_UKV) { tr_item(p.wukv, 256, 1024, WUKV, 256, 0, 0, 0, scr, r, lane); continue; } r -= I_UKV;
            if (r < 4 * I_POOL) { const int g = r / I_POOL; tr_item(p.pool_w + (size_t)g * 128 * 128, 128, 128, WPOOL, 512, g * 128, g * 128, 0, scr, r % I_POOL, lane); continue; } r -= 4 * I_POOL;
            if (r < I_O) { tr_item(p.wouta, D, D, WOA, D, 0, 0, 0, scr, r, lane); continue; } r -= I_O;
            if (r < I_O) { tr_item(p.woutd, D, D, WOD, D, 0, 0, 0, scr, r, lane); continue; } r -= I_O;
            if (r < I_QKV) { tr_item(p.wqkv, D, 3072, WQKV, D, 0, 0, 2, scr, r, lane); continue; } r -= I_QKV;
            if (r < I_GU) { tr_item(p.wgu, D, 2 * DFF, WGU0, D, 0, 0, 1, scr, r, lane); continue; } r -= I_GU;
            if (r < I_GU) { tr_item(p.wgu + (size_t)D * 2 * DFF, D, 2 * DFF, WGU1, D, 0, 0, 1, scr, r, lane); continue; } r -= I_GU;
            if (r < I_D) { tr_item(p.wd, DFF, D, WD0, DFF, 0, 0, 0, scr, r, lane); continue; } r -= I_D;
            tr_item(p.wd + (size_t)DFF * D, DFF, D, WD1, DFF, 0, 0, 0, scr, r, lane);
        }
        const int gt = vcu * 512 + tid, ngt = G * 512;
        for (int i = gt; i < (INA_P - INA) * D / 8; i += ngt) ((u32x4*)(WIN + (size_t)INA * D))[i] = (u32x4){0u, 0u, 0u, 0u};
        for (int i = gt; i < 3 * T / 4; i += ngt) ((f32x4*)SS)[i] = (f32x4){0.f, 0.f, 0.f, 0.f};
        for (int i = gt; i < 512 * 64; i += ngt) { const int row = i >> 6, c8 = i & 63; if ((row >> 7) != (c8 >> 4)) ((u32x4*)WPOOL)[i] = (u32x4){0u, 0u, 0u, 0u}; }
        for (int i = gt; i < SM_TOTAL; i += ngt) {
            float v;
            if (i < SM_N2G) v = p.n1g[i]; else if (i < SM_QNG) v = p.n2g[i - SM_N2G]; else if (i < SM_KVNG) v = p.qng[i - SM_QNG]; else if (i < SM_POOLB) v = p.kvng[i - SM_KVNG];
            else if (i < SM_POOLS) v = p.pool_b[i - SM_POOLB]; else if (i < SM_LQ1) v = p.pool_s[i - SM_POOLS]; else if (i < SM_LK1) v = p.lq1[i - SM_LQ1]; else if (i < SM_LQ2) v = p.lk1[i - SM_LK1];
            else if (i < SM_LK2) v = p.lq2[i - SM_LQ2]; else if (i < SM_SUBLN) v = p.lk2[i - SM_LK2]; else if (i < SM_FNG) v = p.subln[i - SM_SUBLN]; else v = p.fng[i - SM_FNG];
            SM[i] = v;
        }
        for (int t = gt; t < T; t += ngt) {
            const float pf = (float)p.pos[t];
#pragma unroll
            for (int i = 0; i < 16; ++i) { const float ang = pf * exp2f(-(float)(2 * i) / 32.0f * 18.931568569324174f); double rev = (double)ang * 0.15915494309189535; rev -= rint(rev);
                COSR[(size_t)t * 16 + i] = __builtin_amdgcn_cosf((float)rev); SINR[(size_t)t * 16 + i] = __builtin_amdgcn_sinf((float)rev); }
#pragma unroll
            for (int i = 0; i < 8; ++i) { const float ang = pf * exp2f(-(float)(2 * i) / 16.0f * 18.931568569324174f); double rev = (double)ang * 0.15915494309189535; rev -= rint(rev);
                COSP[(size_t)t * 8 + i] = __builtin_amdgcn_cosf((float)rev); SINP[(size_t)t * 8 + i] = __builtin_amdgcn_sinf((float)rev); }
        }
    }
    grid.sync();
    const XcdBarrier xbar = xcd_barrier_post(BARW, bst);

    const float* mod0 = MOD; const float* mod1 = MOD + 8 * 6144;
    {
        const int tid = opq_tid(), lane = tid & 63, wave = __builtin_amdgcn_readfirstlane(tid >> 6), gw = vcu * 8 + wave, ngw = G * 8, gt = vcu * 512 + tid, ngt = G * 512;
        for (int i = gt; i < 3 * 8 * 1024; i += ngt) { const int k = i >> 13, b = (i >> 10) & 7, c = i & 1023;
            const float g = (k == 0) ? SM[SM_N2G + c] : (k == 1) ? SM[SM_N1G + 1024 + c] : SM[SM_N2G + 1024 + c];
            const float sc = (k == 0) ? mod0[b * 6144 + 4096 + c] : (k == 1) ? mod1[b * 6144 + 1024 + c] : mod1[b * 6144 + 4096 + c];
            ATAB[i] = g * (1.0f + sc); }
        for (int r = gw; r < 5632 + 3072 + 5632; r += ngw) {
            const bf16_t* wrow; const float* sh; float* dst; int ncol;
            if (r < 5632) { wrow = WGU0 + (size_t)r * 1024; sh = mod0 + 3072; dst = BT + BT_GU0 + r; ncol = 5632; }
            else if (r < 5632 + 3072) { wrow = WQKV + (size_t)(r - 5632) * 1024; sh = mod1; dst = BT + BT_QKV + (r - 5632); ncol = 3072; }
            else { wrow = WGU1 + (size_t)(r - 5632 - 3072) * 1024; sh = mod1 + 3072; dst = BT + BT_GU1 + (r - 5632 - 3072); ncol = 5632; }
            const u32x4 w0 = *(const u32x4*)(wrow + 16 * lane), w1 = *(const u32x4*)(wrow + 16 * lane + 8);
            const float wf[16] = {bflo(w0.x), bfhi(w0.x), bflo(w0.y), bfhi(w0.y), bflo(w0.z), bfhi(w0.z), bflo(w0.w), bfhi(w0.w), bflo(w1.x), bfhi(w1.x), bflo(w1.y), bfhi(w1.y), bflo(w1.z), bfhi(w1.z), bflo(w1.w), bfhi(w1.w)};
#pragma unroll
            for (int b = 0; b < 8; ++b) { const f32x4* sp = (const f32x4*)(sh + b * 6144 + 16 * lane); float a = 0.f;
#pragma unroll
                for (int j = 0; j < 4; ++j) { const f32x4 sv = sp[j]; a += sv[0] * wf[4 * j] + sv[1] * wf[4 * j + 1] + sv[2] * wf[4 * j + 2] + sv[3] * wf[4 * j + 3]; }
                a = wave_sum(a); if (lane == 0) dst[(size_t)b * ncol] = a; }
        }
    }
    norm_pass(p.x, SM + SM_N1G, mod0, 0, 1024, XN, vcu, G);
    xcd_barrier(xbar);
    { pg8::Gemm g{XN, WIN, T, INA_P, D}; pg8::StaticOrder S; S.init(T, INA_P, G, bx); pg8::EpiStore E{PROJ, INA_P, nullptr, nullptr};
      pg8::gemm_phase<pg8::EpiStore, pg8::StaticOrder, true, true>(lds, g, S, E); }
    xcd_barrier(xbar);
    mid_pass(PROJ, SM + SM_QNG, SM + SM_KVNG, COSR, SINR, CQN, CKVN, KR, POOLED, vcu, G);
    xcd_barrier(xbar);
    { pg8::Gemm g{CQN, WUQ, T, 768, 384}; pg8::StaticOrder S; S.init(T, 768, G, bx); pg8::EpiQMla E{QM, COSR, SINR, 0.10206207261596577f * LOG2E};
      pg8::gemm_phase<pg8::EpiQMla, pg8::StaticOrder, true, true>(lds, g, S, E); }
    { pg8::Gemm g{CKVN, WUKV, T, 1024, 256}; pg8::StaticOrder S; S.init(T, 1024, G, bx); pg8::EpiKvHead E{KV};
      pg8::gemm_phase<pg8::EpiKvHead, pg8::StaticOrder, true, true>(lds, g, S, E); }
    { pg8::Gemm g{POOLED, WPOOL, T, 512, 512}; pg8::StaticOrder S; S.init(T, 512, G, bx); pg8::EpiStore E{XN + 512, 1024, SM + SM_POOLB, SM + SM_POOLS};
      pg8::gemm_phase<pg8::EpiStore, pg8::StaticOrder, true, true>(lds, g, S, E); }
    xcd_barrier(xbar);
    for (int u = vcu; u < NB * 8 * 8; u += G) {
        const int pair = u & 7, bh = u >> 3, b = bh >> 3, h = bh & 7;
        for (int half = 0; half < 2; ++half) {
            const int q0 = (half == 0 ? 15 - pair : pair) * 256;
            f32x16 o[2];
            attn_qblock<96, 64, 64>(QM + (size_t)bh * SEQ * 96, 96, KV + (size_t)bh * SEQ * 64, 64, KR + (size_t)b * SEQ * 32, 32,
                                    KV + 16777216 + (size_t)bh * SEQ * 64, 64, q0, lds, o);
            attn_store<96, 64>(o, XN + (size_t)(b * SEQ + q0) * 1024 + h * 64, 1024, lds);
        }
    }
    xcd_barrier(xbar);
    { pg8::Gemm g{XN, WOA, T, D, D}; pg8::StaticOrder S; S.init(T, D, G, bx); pg8::EpiResN E{p.x, XR, mod0 + 2048, 6144, XA, ATAB, SS};
      pg8::gemm_phase<pg8::EpiResN, pg8::StaticOrder, true, true>(lds, g, S, E); }
    xcd_barrier(xbar);
    { pg8::Gemm g{XA, WGU0, T, 2 * DFF, D}; pg8::StaticOrder S; S.init(T, 2 * DFF, G, bx); pg8::EpiSwiglu E{HB, DFF, SS, BT + BT_GU0};
      pg8::gemm_phase<pg8::EpiSwiglu, pg8::StaticOrder, true, true>(lds, g, S, E); }
    xcd_barrier(xbar);
    { pg8::Gemm g{HB, WD0, T, D, DFF}; pg8::StaticOrder S; S.init(T, D, G, bx); pg8::EpiResN E{XR, XR, mod0 + 5120, 6144, XN, ATAB + 8192, SS + T};
      pg8::gemm_phase<pg8::EpiResN, pg8::StaticOrder, true, true>(lds, g, S, E); }
    xcd_barrier(xbar);
    { pg8::Gemm g{XN, WQKV, T, 3072, D}; pg8::StaticOrder S; S.init(T, 3072, G, bx); pg8::EpiQkvDiff E{QKV, COSP, SINP, 0.125f * LOG2E, SS + T, BT + BT_QKV};
      pg8::gemm_phase<pg8::EpiQkvDiff, pg8::StaticOrder, true, true>(lds, g, S, E); }
    xcd_barrier(xbar);
    {
        float d1 = 0.f, d2 = 0.f;
        for (int i = 0; i < 64; ++i) { d1 += SM[SM_LQ1 + i] * SM[SM_LK1 + i]; d2 += SM[SM_LQ2 + i] * SM[SM_LK2 + i]; }
        const float lam = expf(d1) - expf(d2) + LAMBDA_INIT;
        float* stash = STASH + (size_t)bx * (64 * 512);
        const int tid = opq_tid(), hi = (tid & 63) >> 5;
        for (int u = vcu; u < NB * 8 * 8; u += G) {
            const int pair = u & 7, bh = u >> 3, b = bh >> 3, h = bh & 7;
            for (int half = 0; half < 2; ++half) {
                const int q0 = (half == 0 ? 15 - pair : pair) * 256;
                f32x16 o[4];
#pragma unroll 1
                for (int c = 0; c < 2; ++c) {
                    attn_qblock<64, 64, 128>(QKV + (size_t)(b * 16 + 2 * h + c) * SEQ * 64, 64, QKV + 33554432 + (size_t)(b * 16 + 2 * h + c) * SEQ * 64, 64, QKV, 64,
                                             QKV + (size_t)2 * 33554432 + (size_t)bh * SEQ * 128, 128, q0, lds, o);
                    if (c == 0) {
                        float* sp = stash + tid * 4;
#pragma unroll
                        for (int v = 0; v < 4; ++v)
#pragma unroll
                            for (int g4 = 0; g4 < 4; ++g4) { *(f32x4*)sp = (f32x4){o[v][4 * g4], o[v][4 * g4 + 1], o[v][4 * g4 + 2], o[v][4 * g4 + 3]}; sp += 2048; asm volatile("" : "+v"(sp)); }
                    }
                }
                float ss = 0.f; const float* sq = stash + tid * 4;
#pragma unroll
                for (int v = 0; v < 4; ++v) {
#pragma unroll
                    for (int g4 = 0; g4 < 4; ++g4) { const f32x4 sv = *(const f32x4*)sq; sq += 2048; asm volatile("" : "+v"(sq));
#pragma unroll
                        for (int e = 0; e < 4; ++e) { const float d = sv[e] - lam * o[v][4 * g4 + e]; o[v][4 * g4 + e] = d; ss += d * d; } }
                    asm volatile("" ::: "memory"); }
                ss += __shfl_xor(ss, 32);
                const float rstd = (1.0f - LAMBDA_INIT) / sqrtf(ss * (1.0f / 128.0f) + EPS);
#pragma unroll
                for (int v = 0; v < 4; ++v)
#pragma unroll
                    for (int g4 = 0; g4 < 4; ++g4) { const f32x4 gv = *(const f32x4*)(SM + SM_SUBLN + 32 * v + 8 * g4 + 4 * hi);
#pragma unroll
                        for (int e = 0; e < 4; ++e) o[v][4 * g4 + e] *= rstd * gv[e]; }
                attn_store<64, 128>(o, XN + (size_t)(b * SEQ + q0) * 1024 + h * 128, 1024, lds);
            }
        }
    }
    xcd_barrier(xbar);
    { pg8::Gemm g{XN, WOD, T, D, D}; pg8::StaticOrder S; S.init(T, D, G, bx); pg8::EpiResN E{XR, XR, mod1 + 2048, 6144, XA, ATAB + 2 * 8192, SS + 2 * T};
      pg8::gemm_phase<pg8::EpiResN, pg8::StaticOrder, true, true>(lds, g, S, E); }
    xcd_barrier(xbar);
    { pg8::Gemm g{XA, WGU1, T, 2 * DFF, D}; pg8::StaticOrder S; S.init(T, 2 * DFF, G, bx); pg8::EpiSwiglu E{HB, DFF, SS + 2 * T, BT + BT_GU1};
      pg8::gemm_phase<pg8::EpiSwiglu, pg8::StaticOrder, true, true>(lds, g, S, E); }
    xcd_barrier(xbar);
    { pg8::Gemm g{HB, WD1, T, D, DFF}; pg8::StaticOrder S; S.init(T, D, G, bx); pg8::EpiRes E{XR, XR, mod1 + 5120, 6144};
      pg8::gemm_phase<pg8::EpiRes, pg8::StaticOrder, true, true>(lds, g, S, E); }
    xcd_barrier(xbar);
    final_norm(XR, SM + SM_FNG, p.out, vcu, G);
}

extern "C" void kernel_launch(void* const* d_in, const int* in_sizes, int n_in, void* d_out, int out_size, void* d_ws, size_t ws_size, hipStream_t stream) {
    static int grid = 0;
    if (grid == 0) {
        if (n_in != 26 || in_sizes[0] != T * D || out_size != T * D || ws_size < WS_END) { fprintf(stderr, "kernel_launch: unexpected shapes (n_in %d, in0 %d, out %d, ws %zu)\n", n_in, n_in > 0 ? in_sizes[0] : -1, out_size, ws_size); grid = -1; return; }
        int dev = 0, cus = 0, per_cu = 0;
        if (hipGetDevice(&dev) != hipSuccess || hipDeviceGetAttribute(&cus, hipDeviceAttributeMultiprocessorCount, dev) != hipSuccess) { grid = -1; return; }
        if (hipFuncSetAttribute((const void*)fwd_megakernel, hipFuncAttributeMaxDynamicSharedMemorySize, LDS_BYTES) != hipSuccess) { fprintf(stderr, "kernel_launch: hipFuncSetAttribute failed\n"); grid = -1; return; }
        if (hipOccupancyMaxActiveBlocksPerMultiprocessor(&per_cu, (const void*)fwd_megakernel, 512, LDS_BYTES) != hipSuccess || per_cu < 1) { fprintf(stderr, "kernel_launch: occupancy query gave %d\n", per_cu); per_cu = 1; }
        (void)hipGetLastError();
        grid = cus * (per_cu > 1 ? 1 : per_cu);
    }
    if (grid < 0) return;
    Params p{};
    p.x = (const float*)d_in[0]; p.c = (const float*)d_in[1]; p.pos = (const int*)d_in[2];
    p.ada_w = (const float*)d_in[3]; p.ada_b = (const float*)d_in[4]; p.n1g = (const float*)d_in[5]; p.n2g = (const float*)d_in[6];
    p.wgu = (const float*)d_in[7]; p.wd = (const float*)d_in[8]; p.w_in = (const float*)d_in[9]; p.qng = (const float*)d_in[10]; p.kvng = (const float*)d_in[11];
    p.wuq = (const float*)d_in[12]; p.wukv = (const float*)d_in[13]; p.pool_w = (const float*)d_in[14]; p.pool_b = (const float*)d_in[15]; p.pool_s = (const float*)d_in[16];
    p.wouta = (const float*)d_in[17]; p.wqkv = (const float*)d_in[18]; p.lq1 = (const float*)d_in[19]; p.lk1 = (const float*)d_in[20]; p.lq2 = (const float*)d_in[21]; p.lk2 = (const float*)d_in[22];
    p.subln = (const float*)d_in[23]; p.woutd = (const float*)d_in[24]; p.fng = (const float*)d_in[25];
    p.out = (float*)d_out; p.ws = (unsigned char*)d_ws;
    void* args[] = {&p};
    hipError_t e = hipLaunchCooperativeKernel((const void*)fwd_megakernel, dim3(grid), dim3(512), args, LDS_BYTES, stream);
    if (e != hipSuccess) fprintf(stderr, "kernel_launch: cooperative launch failed: %s (grid %d)\n", hipGetErrorString(e), grid);
}
```

```cpp
#include <hip/hip_runtime.h>
#include <hip/hip_cooperative_groups.h>
#include <cstdio>
#include <cstdint>
#include <cmath>
namespace cg = cooperative_groups;

namespace pg8 {
#define PG8_LAS __attribute__((address_space(3)))
typedef unsigned short bf16_t;
typedef short bf16x8 __attribute__((ext_vector_type(8)));
typedef float f32x4 __attribute__((ext_vector_type(4)));
typedef unsigned u32x4 __attribute__((ext_vector_type(4)));
constexpr int BM = 256, BK = 64, HALF = 128, HTB = HALF * BK * 2  , STAGE_BYTES = 8 * HTB, NXCD = 8, WGM = 8;

__host__ __device__ __forceinline__ int lds_byte(int r, int c) { const int st = (r >> 4) * 2 + (c >> 5), rr = r & 15, cc = c & 31, ob = rr * 64 + cc * 2; return st * 1024 + (ob ^ (((ob >> 9) & 1) << 5)); }
__host__ __device__ __forceinline__ void stage_rc(int b, int& R, int& C) { const int st = b / 1024, sb = b % 1024, swz = sb ^ (((sb >> 9) & 1) << 5); R = (st >> 1) * 16 + swz / 64; C = (st & 1) * 32 + (swz % 64) / 2; }
__host__ __device__ __forceinline__ int perm32(int rho) { const int n = rho >> 4, i = rho & 15; return 8 * (i >> 2) + 4 * n + (i & 3); }

struct Unit { int pm, pn; };
struct Gemm { const bf16_t* A; const bf16_t* Bt; int M, N, K; };

struct StaticOrder {
    int nM, nN, nwg, G, c;
    __host__ __device__ void init(int M, int N, int G_, int c_) { nM = M / BM; nN = N / BM; nwg = nM * nN; G = G_; c = c_; }
    __host__ __device__ bool next(int i, Unit& u) const {
        const long L = (long)i * G + c; if (L >= nwg) return false;
        int wgid = (int)L; { const int q = nwg / NXCD, r = nwg % NXCD, xcd = wgid % NXCD, off = wgid / NXCD; wgid = (xcd < r ? xcd * (q + 1) : r * (q + 1) + (xcd - r) * q) + off; }
        const int nig = WGM * nN, gid = wgid / nig, fm = gid * WGM, gsz = (nM - fm) < WGM ? (nM - fm) : WGM;
        u.pm = fm + ((wgid % nig) % gsz); u.pn = (wgid % nig) / gsz; return true;
    }
    __device__ __forceinline__ void a_ready(const Unit&) const {}
    __device__ __forceinline__ void done(const Unit&) const {}
};

__device__ __forceinline__ unsigned cvt_pk_bf16(float lo, float hi) { unsigned r; asm volatile("v_cvt_pk_bf16_f32 %0, %1, %2" : "=v"(r) : "v"(lo), "v"(hi)); return r; }
typedef unsigned u32x2 __attribute__((ext_vector_type(2)));
typedef float f32x2 __attribute__((ext_vector_type(2)));
template <class Epi, class Sched, bool ALIGN_EPI = false, bool SP2 = false>
__device__ __forceinline__ void gemm_phase(PG8_LAS unsigned char* lds, const Gemm g, const Sched& S, const Epi& E) {
    int tid_ = threadIdx.x; asm volatile("" : "+v"(tid_));
    const int tid = tid_, wid = __builtin_amdgcn_readfirstlane(tid >> 6), lane = tid & 63, wr = wid >> 2, wc = wid & 3, fr = lane & 15, fq = lane >> 4;
    int K_ = g.K; asm volatile("" : "+s"(K_));
    const int K = K_, nt = K / BK;
    unsigned voffA[2], voffB[2];
#pragma unroll
    for (int i = 0; i < 2; ++i) { int R, C; stage_rc(tid * 16 + i * 8192, R, C); const int Rb = Epi::PERM ? ((R & ~31) + perm32(R & 31)) : R;
        voffA[i] = (unsigned)(R * K + C) * 2u; voffB[i] = (unsigned)(Rb * K + C) * 2u; }
    const size_t kstep = (size_t)(BK * 2);
    const size_t hstep = (size_t)HALF * K * 2;
    const size_t tstep = 2 * hstep;
    const unsigned ldsw = (unsigned)wid * 1024u;
    const int aoff = lds_byte(wr * 64 + fr, fq * 8), boff = lds_byte(wc * 32 + fr, fq * 8);
#define PG8_SA(b, h) (((b) * 2 + (h)) * HTB)
#define PG8_SB(b, h) ((4 + (b) * 2 + (h)) * HTB)
#define PG8_STAGE(bufoff, gbase, voff) do { _Pragma("unroll") for (int _i = 0; _i < 2; ++_i) \
        __builtin_amdgcn_global_load_lds((const unsigned*)((const char*)(gbase) + (voff)[_i]), (PG8_LAS unsigned*)(lds + (bufoff) + ldsw + _i * 8192), 16, 0, 0); } while (0)
#define PG8_LDA(dst, b, h) do { _Pragma("unroll") for (int m = 0; m < 4; ++m) _Pragma("unroll") for (int k = 0; k < 2; ++k) dst[m][k] = *(const PG8_LAS bf16x8*)(lds + PG8_SA(b, h) + aoff + m * 2048 + k * 1024); } while (0)
#define PG8_LDB(dst, b, h) do { _Pragma("unroll") for (int n = 0; n < 2; ++n) _Pragma("unroll") for (int k = 0; k < 2; ++k) dst[n][k] = *(const PG8_LAS bf16x8*)(lds + PG8_SB(b, h) + boff + n * 2048 + k * 1024); } while (0)
#define PG8_MMA(ai, bj, At, Bt) do { __builtin_amdgcn_s_setprio(1); _Pragma("unroll") for (int m = 0; m < 4; ++m) _Pragma("unroll") for (int n = 0; n < 2; ++n) _Pragma("unroll") for (int k = 0; k < 2; ++k) \
        acc[ai][bj][m][n] = __builtin_amdgcn_mfma_f32_16x16x32_bf16(Bt[n][k], At[m][k], acc[ai][bj][m][n], 0, 0, 0); __builtin_amdgcn_s_setprio(0); } while (0)
#define PG8_WAIT_V(n) asm volatile("s_waitcnt vmcnt(" #n ")" ::: "memory")
#define PG8_WAIT_L(n) asm volatile("s_waitcnt lgkmcnt(" #n ")" ::: "memory")
#define PG8_BAR __builtin_amdgcn_s_barrier()
#define PG8_SCHED __builtin_amdgcn_sched_barrier(0)
    Unit cur, nxt; int ui = 0;
    if (!S.next(0, cur)) return;
    f32x4 acc[2][2][4][2];
#pragma unroll
    for (int a = 0; a < 2; ++a)
#pragma unroll
        for (int b = 0; b < 2; ++b)
#pragma unroll
            for (int m = 0; m < 4; ++m)
#pragma unroll
                for (int n = 0; n < 2; ++n) acc[a][b][m][n] = (f32x4){0.f, 0.f, 0.f, 0.f};
    bf16x8 At[4][2], B0[2][2], B1[2][2];
    const char* cA = (const char*)g.A + (size_t)cur.pm * tstep; const char* cB = (const char*)g.Bt + (size_t)cur.pn * tstep;
    S.a_ready(cur);
    if constexpr (SP2) {
        PG8_STAGE(PG8_SB(0, 0), cB, voffB); PG8_STAGE(PG8_SB(0, 1), cB + hstep, voffB); PG8_STAGE(PG8_SA(0, 0), cA, voffA); PG8_STAGE(PG8_SA(0, 1), cA + hstep, voffA);
        if (wr == 1) PG8_BAR;
        PG8_WAIT_V(2); PG8_BAR;
        PG8_STAGE(PG8_SB(1, 0), cB + kstep, voffB); PG8_STAGE(PG8_SA(1, 0), cA + kstep, voffA); PG8_STAGE(PG8_SB(1, 1), cB + hstep + kstep, voffB);
        PG8_WAIT_V(6); PG8_BAR;
    } else {
        PG8_STAGE(PG8_SB(0, 0), cB, voffB); PG8_STAGE(PG8_SA(0, 0), cA, voffA); PG8_STAGE(PG8_SB(0, 1), cB + hstep, voffB); PG8_STAGE(PG8_SA(0, 1), cA + hstep, voffA);
        if (wr == 1) PG8_BAR;
        PG8_WAIT_V(4); PG8_BAR;
        PG8_STAGE(PG8_SB(1, 0), cB + kstep, voffB); PG8_STAGE(PG8_SA(1, 0), cA + kstep, voffA); PG8_STAGE(PG8_SB(1, 1), cB + hstep + kstep, voffB);
        PG8_WAIT_V(6); PG8_BAR;
    }
    for (;;) {
        const bool has_next = S.next(ui + 1, nxt);
        const char* nA = has_next ? (const char*)g.A + (size_t)nxt.pm * tstep : cA; const char* nB = has_next ? (const char*)g.Bt + (size_t)nxt.pn * tstep : cB;
        for (int t = 0; t < nt; t += 2) {
            const bool last = (t == nt - 2);
            const char* a1 = cA + (size_t)(t + 1) * kstep;
            const char* a2 = last ? nA : cA + (size_t)(t + 2) * kstep; const char* b2 = last ? nB : cB + (size_t)(t + 2) * kstep;
            const char* a3 = a2 + kstep; const char* b3 = b2 + kstep;
            if (last && has_next) S.a_ready(nxt);
            if constexpr (SP2) {
            PG8_LDB(B0, 0, 0); PG8_LDB(B1, 0, 1); PG8_SCHED; PG8_LDA(At, 0, 0); PG8_STAGE(PG8_SA(1, 1), a1 + hstep, voffA);
            PG8_WAIT_V(8); PG8_WAIT_L(0); PG8_BAR; PG8_MMA(0, 0, At, B0); PG8_MMA(0, 1, At, B1); PG8_BAR; PG8_SCHED;
            PG8_LDA(At, 0, 1); PG8_STAGE(PG8_SB(0, 0), b2, voffB); PG8_STAGE(PG8_SB(0, 1), b2 + hstep, voffB); PG8_STAGE(PG8_SA(0, 0), a2, voffA);
            PG8_WAIT_V(8); PG8_WAIT_L(0); PG8_BAR; PG8_MMA(1, 0, At, B0); PG8_MMA(1, 1, At, B1); PG8_BAR; PG8_SCHED;
            PG8_LDB(B0, 1, 0); PG8_LDB(B1, 1, 1); PG8_SCHED; PG8_LDA(At, 1, 0); PG8_STAGE(PG8_SA(0, 1), a2 + hstep, voffA);
            PG8_WAIT_V(8); PG8_WAIT_L(0); PG8_BAR; PG8_MMA(0, 0, At, B0); PG8_MMA(0, 1, At, B1); PG8_BAR; PG8_SCHED;
            PG8_LDA(At, 1, 1); PG8_STAGE(PG8_SB(1, 0), b3, voffB); PG8_STAGE(PG8_SB(1, 1), b3 + hstep, voffB); PG8_STAGE(PG8_SA(1, 0), a3, voffA);
            PG8_WAIT_V(8); PG8_WAIT_L(0); PG8_BAR; PG8_MMA(1, 0, At, B0); PG8_MMA(1, 1, At, B1); PG8_BAR; PG8_SCHED;
            } else {
            PG8_LDB(B0, 0, 0); PG8_SCHED; PG8_LDA(At, 0, 0); PG8_STAGE(PG8_SA(1, 1), a1 + hstep, voffA);
            PG8_WAIT_L(8); PG8_BAR; PG8_WAIT_L(0); PG8_MMA(0, 0, At, B0); PG8_BAR; PG8_SCHED;
            PG8_LDB(B1, 0, 1); PG8_STAGE(PG8_SB(0, 0), b2, voffB);
            PG8_BAR; PG8_WAIT_L(0); PG8_MMA(0, 1, At, B1); PG8_BAR;
            PG8_LDA(At, 0, 1); PG8_STAGE(PG8_SA(0, 0), a2, voffA);
            PG8_BAR; PG8_WAIT_L(0); PG8_MMA(1, 0, At, B0); PG8_BAR; PG8_SCHED;
            PG8_STAGE(PG8_SB(0, 1), b2 + hstep, voffB);
            PG8_WAIT_V(6); PG8_BAR; PG8_MMA(1, 1, At, B1); PG8_BAR;
            PG8_LDB(B0, 1, 0); PG8_SCHED; PG8_LDA(At, 1, 0); PG8_STAGE(PG8_SA(0, 1), a2 + hstep, voffA);
            PG8_WAIT_L(8); PG8_BAR; PG8_WAIT_L(0); PG8_MMA(0, 0, At, B0); PG8_BAR; PG8_SCHED;
            PG8_LDB(B1, 1, 1); PG8_STAGE(PG8_SB(1, 0), b3, voffB);
            PG8_BAR; PG8_WAIT_L(0); PG8_MMA(0, 1, At, B1); PG8_BAR;
            PG8_LDA(At, 1, 1); PG8_STAGE(PG8_SA(1, 0), a3, voffA);
            PG8_BAR; PG8_WAIT_L(0); PG8_MMA(1, 0, At, B0); PG8_BAR; PG8_SCHED;
            PG8_STAGE(PG8_SB(1, 1), b3 + hstep, voffB);
            PG8_WAIT_V(6); PG8_BAR; PG8_MMA(1, 1, At, B1); PG8_BAR;
            }
        }
        if constexpr (ALIGN_EPI) { if (wr == 0) PG8_BAR; }
        if constexpr (!Epi::AFTER_DRAIN) { int l2_ = threadIdx.x; asm volatile("" : "+v"(l2_)); l2_ &= 63; E(acc, cur, wr, wc, l2_ & 15, l2_ >> 4); S.done(cur); }
        if (!has_next) break;
#pragma unroll
        for (int a = 0; a < 2; ++a)
#pragma unroll
            for (int b = 0; b < 2; ++b)
#pragma unroll
                for (int m = 0; m < 4; ++m)
#pragma unroll
                    for (int n = 0; n < 2; ++n) acc[a][b][m][n] = (f32x4){0.f, 0.f, 0.f, 0.f};
        cur = nxt; cA = nA; cB = nB; ++ui;
        if constexpr (ALIGN_EPI) { if (wr == 1) PG8_BAR; }
    }
    PG8_WAIT_V(0);
    if constexpr (!ALIGN_EPI) { if (wr == 0) PG8_BAR; }
    PG8_BAR;
    if constexpr (Epi::AFTER_DRAIN) { E.fused(acc, cur, wr, wc, fr, fq, lds, wid, lane); S.done(cur); }
#undef PG8_SA
#undef PG8_SB
#undef PG8_STAGE
#undef PG8_LDA
#undef PG8_LDB
#undef PG8_MMA
#undef PG8_WAIT_V
#undef PG8_WAIT_L
#undef PG8_BAR
#undef PG8_SCHED
}

struct EpiStore {
    static constexpr bool PERM = true, AFTER_DRAIN = false;
    bf16_t* O; int ldc; const float* bias; const float* cs;
    __device__ __forceinline__ void operator()(const f32x4 (&acc)[2][2][4][2], const Unit& u, int wr, int wc, int fr, int fq) const {
        const int row0 = u.pm * BM + wr * 64 + fr, col0 = u.pn * BM + wc * 32 + 8 * fq;
        f32x4 bv[2][2], sv[2][2];
#pragma unroll
        for (int bj = 0; bj < 2; ++bj)
#pragma unroll
            for (int n = 0; n < 2; ++n) { bv[bj][n] = bias ? *(const f32x4*)(bias + col0 + bj * HALF + 4 * n) : (f32x4){0.f, 0.f, 0.f, 0.f};
                                          sv[bj][n] = cs ? *(const f32x4*)(cs + col0 + bj * HALF + 4 * n) : (f32x4){1.f, 1.f, 1.f, 1.f}; }
#pragma unroll
        for (int ai = 0; ai < 2; ++ai)
#pragma unroll
            for (int m = 0; m < 4; ++m) { bf16_t* rowp = O + (size_t)(row0 + ai * HALF + m * 16) * ldc + col0;
#pragma unroll
                for (int bj = 0; bj < 2; ++bj) { const f32x4 v0 = (acc[ai][bj][m][0] + bv[bj][0]) * sv[bj][0], v1 = (acc[ai][bj][m][1] + bv[bj][1]) * sv[bj][1];
                    u32x4 w; w.x = cvt_pk_bf16(v0[0], v0[1]); w.y = cvt_pk_bf16(v0[2], v0[3]); w.z = cvt_pk_bf16(v1[0], v1[1]); w.w = cvt_pk_bf16(v1[2], v1[3]);
                    *(u32x4*)(rowp + bj * HALF) = w; } }
    }
};
struct EpiKvHead {
    static constexpr bool PERM = true, AFTER_DRAIN = false;
    bf16_t* O;
    __device__ __forceinline__ void operator()(const f32x4 (&acc)[2][2][4][2], const Unit& u, int wr, int wc, int fr, int fq) const {
        const int row0 = u.pm * BM + wr * 64 + fr, col0 = u.pn * BM + wc * 32 + 8 * fq;
#pragma unroll
        for (int ai = 0; ai < 2; ++ai)
#pragma unroll
            for (int m = 0; m < 4; ++m) { const int row = row0 + ai * HALF + m * 16; const size_t bs = (size_t)(row >> 12), sq = (size_t)(row & 4095);
#pragma unroll
                for (int bj = 0; bj < 2; ++bj) { const int col = col0 + bj * HALF; const f32x4 v0 = acc[ai][bj][m][0], v1 = acc[ai][bj][m][1];
                    u32x4 w; w.x = cvt_pk_bf16(v0[0], v0[1]); w.y = cvt_pk_bf16(v0[2], v0[3]); w.z = cvt_pk_bf16(v1[0], v1[1]); w.w = cvt_pk_bf16(v1[2], v1[3]);
                    *(u32x4*)(O + (size_t)((col >> 6) & 1) * 16777216 + ((bs * 8 + (col >> 7)) * 4096 + sq) * 64 + (col & 63)) = w; } }
    }
};
struct EpiSwiglu {
    static constexpr bool PERM = true, AFTER_DRAIN = false;
    bf16_t* O; int ldc; const float* SS; const float* bt;
    __device__ __forceinline__ static float sg(float g, float u) { return g * u * __builtin_amdgcn_rcpf(1.0f + __builtin_amdgcn_exp2f(-1.4426950408889634f * g)); }
    __device__ __forceinline__ void operator()(const f32x4 (&acc)[2][2][4][2], const Unit& u, int wr, int wc, int fr, int fq) const {
        const int row0 = u.pm * BM + wr * 64 + fr, col0 = u.pn * BM + wc * 32 + 8 * fq, j0 = u.pn * HALF + wc * 32 + 8 * fq;
        const float* bp = bt + (size_t)((u.pm * BM) >> 12) * (2 * 2816) + col0;
        f32x4 bv[2][2];
#pragma unroll
        for (int bj = 0; bj < 2; ++bj)
#pragma unroll
            for (int n = 0; n < 2; ++n) bv[bj][n] = *(const f32x4*)(bp + bj * HALF + 4 * n);
#pragma unroll
        for (int ai = 0; ai < 2; ++ai)
#pragma unroll
            for (int m = 0; m < 4; ++m) { const int row = row0 + ai * HALF + m * 16;
                const float rstd = __builtin_amdgcn_rsqf(SS[row] * (1.0f / 1024.0f) + 1e-6f);
                const f32x4 g0 = acc[ai][0][m][0] * rstd + bv[0][0], g1 = acc[ai][0][m][1] * rstd + bv[0][1], u0 = acc[ai][1][m][0] * rstd + bv[1][0], u1 = acc[ai][1][m][1] * rstd + bv[1][1];
                u32x4 w; w.x = cvt_pk_bf16(sg(g0[0], u0[0]), sg(g0[1], u0[1])); w.y = cvt_pk_bf16(sg(g0[2], u0[2]), sg(g0[3], u0[3]));
                w.z = cvt_pk_bf16(sg(g1[0], u1[0]), sg(g1[1], u1[1])); w.w = cvt_pk_bf16(sg(g1[2], u1[2]), sg(g1[3], u1[3]));
                *(u32x4*)(O + (size_t)row * ldc + j0) = w; }
    }
};
struct EpiRes {
    static constexpr bool PERM = true, AFTER_DRAIN = false;
    const float* base; float* out; const float* gate; int gstride;
    __device__ __forceinline__ void operator()(const f32x4 (&acc)[2][2][4][2], const Unit& u, int wr, int wc, int fr, int fq) const {
        const int row0 = u.pm * BM + wr * 64 + fr, col0 = u.pn * BM + wc * 32 + 8 * fq;
        const float* gp = gate + (size_t)((u.pm * BM) >> 12) * gstride;
#pragma unroll
        for (int bj = 0; bj < 2; ++bj) { const int col = col0 + bj * HALF; const f32x4 g0 = *(const f32x4*)(gp + col), g1 = *(const f32x4*)(gp + col + 4);
#pragma unroll
            for (int ai = 0; ai < 2; ++ai)
#pragma unroll
                for (int m = 0; m < 4; ++m) { const size_t off = (size_t)(row0 + ai * HALF + m * 16) * 1024 + col;
                    *(f32x4*)(out + off) = *(const f32x4*)(base + off) + g0 * acc[ai][bj][m][0]; *(f32x4*)(out + off + 4) = *(const f32x4*)(base + off + 4) + g1 * acc[ai][bj][m][1]; }
            asm volatile("" ::: "memory"); }
    }
};
struct EpiResN {
    static constexpr bool PERM = true, AFTER_DRAIN = false;
    const float* base; float* out; const float* gate; int gstride; bf16_t* XA; const float* atab; float* SS;
    __device__ __forceinline__ void operator()(const f32x4 (&acc)[2][2][4][2], const Unit& u, int wr, int wc, int fr, int fq) const {
        const int row0 = u.pm * BM + wr * 64 + fr, col0 = u.pn * BM + wc * 32 + 8 * fq; const int b = (u.pm * BM) >> 12;
        const float* gp = gate + (size_t)b * gstride; const float* ap = atab + (size_t)b * 1024;
        float ssq[2][4];
#pragma unroll
        for (int ai = 0; ai < 2; ++ai)
#pragma unroll
            for (int m = 0; m < 4; ++m) ssq[ai][m] = 0.f;
#pragma unroll
        for (int bj = 0; bj < 2; ++bj) { const int col = col0 + bj * HALF;
            const f32x4 g0 = *(const f32x4*)(gp + col), g1 = *(const f32x4*)(gp + col + 4), a0 = *(const f32x4*)(ap + col), a1 = *(const f32x4*)(ap + col + 4);
#pragma unroll
            for (int ai = 0; ai < 2; ++ai)
#pragma unroll
                for (int m = 0; m < 4; ++m) { const size_t off = (size_t)(row0 + ai * HALF + m * 16) * 1024 + col;
                    const f32x4 x0 = *(const f32x4*)(base + off) + g0 * acc[ai][bj][m][0], x1 = *(const f32x4*)(base + off + 4) + g1 * acc[ai][bj][m][1];
                    *(f32x4*)(out + off) = x0; *(f32x4*)(out + off + 4) = x1;
                    ssq[ai][m] += ((x0[0] * x0[0] + x0[1] * x0[1]) + (x0[2] * x0[2] + x0[3] * x0[3])) + ((x1[0] * x1[0] + x1[1] * x1[1]) + (x1[2] * x1[2] + x1[3] * x1[3]));
                    const f32x4 y0 = x0 * a0, y1 = x1 * a1; u32x4 w; w.x = cvt_pk_bf16(y0[0], y0[1]); w.y = cvt_pk_bf16(y0[2], y0[3]); w.z = cvt_pk_bf16(y1[0], y1[1]); w.w = cvt_pk_bf16(y1[2], y1[3]);
                    *(u32x4*)(XA + off) = w; }
            asm volatile("" ::: "memory"); }
#pragma unroll
        for (int ai = 0; ai < 2; ++ai)
#pragma unroll
            for (int m = 0; m < 4; ++m) { float s = ssq[ai][m]; s += __shfl_xor(s, 16); s += __shfl_xor(s, 32);
                if (fq == 0) atomicAdd(SS + row0 + ai * HALF + m * 16, s); }
    }
};
struct EpiQMla {
    static constexpr bool PERM = true, AFTER_DRAIN = false;
    bf16_t* O; const float* cosr; const float* sinr; float qscale;
    __device__ __forceinline__ void operator()(const f32x4 (&acc)[2][2][4][2], const Unit& u, int wr, int wc, int fr, int fq) const {
        const int row0 = u.pm * BM + wr * 64 + fr;
        const int cb0 = u.pn * BM + wc * 32, cb1 = cb0 + HALF; const bool rope0 = ((cb0 >> 5) % 3) == 2, rope1 = ((cb1 >> 5) % 3) == 2;
#pragma unroll
        for (int ai = 0; ai < 2; ++ai)
#pragma unroll
            for (int m = 0; m < 4; ++m) { const int row = row0 + ai * HALF + m * 16;
                f32x4 c = (f32x4){1.f, 1.f, 1.f, 1.f}, s = (f32x4){0.f, 0.f, 0.f, 0.f};
                if (rope0 || rope1) { c = *(const f32x4*)(cosr + (size_t)row * 16 + 4 * fq); s = *(const f32x4*)(sinr + (size_t)row * 16 + 4 * fq); }
#pragma unroll
                for (int bj = 0; bj < 2; ++bj) { const bool rope = bj ? rope1 : rope0; f32x4 a = acc[ai][bj][m][0], b = acc[ai][bj][m][1];
                    if (rope) { const f32x4 a2 = (f32x4){a[0] * c[0] - a[1] * s[0], a[1] * c[0] + a[0] * s[0], a[2] * c[1] - a[3] * s[1], a[3] * c[1] + a[2] * s[1]};
                                const f32x4 b2 = (f32x4){b[0] * c[2] - b[1] * s[2], b[1] * c[2] + b[0] * s[2], b[2] * c[3] - b[3] * s[3], b[3] * c[3] + b[2] * s[3]}; a = a2; b = b2; }
                    a = a * qscale; b = b * qscale;
                    u32x4 w; w.x = cvt_pk_bf16(a[0], a[1]); w.y = cvt_pk_bf16(a[2], a[3]); w.z = cvt_pk_bf16(b[0], b[1]); w.w = cvt_pk_bf16(b[2], b[3]);
                    const int col = (bj ? cb1 : cb0) + 8 * fq, hd = col / 96;
                    *(u32x4*)(O + ((size_t)((row >> 12) * 8 + hd) * 4096 + (row & 4095)) * 96 + (col - hd * 96)) = w; }
                asm volatile("" ::: "memory"); }
    }
};
struct EpiQkvDiff {
    static constexpr bool PERM = true, AFTER_DRAIN = false;
    bf16_t* O; const float* cosp; const float* sinp; float qscale; const float* SS; const float* bt;
    __device__ __forceinline__ void operator()(const f32x4 (&acc)[2][2][4][2], const Unit& u, int wr, int wc, int fr, int fq) const {
        const int row0 = u.pm * BM + wr * 64 + fr, col0 = u.pn * BM + wc * 32 + 8 * fq;
        const bool isq = u.pn < 4, ropew = (u.pn < 8) && ((wc & 1) == 0); const float sc = isq ? qscale : 1.0f; const bool ropel = fq < 2;
        const float* bp = bt + (size_t)((u.pm * BM) >> 12) * 3072 + col0;
        f32x4 bv[2][2];
#pragma unroll
        for (int bj = 0; bj < 2; ++bj)
#pragma unroll
            for (int n = 0; n < 2; ++n) bv[bj][n] = *(const f32x4*)(bp + bj * HALF + 4 * n);
#pragma unroll
        for (int ai = 0; ai < 2; ++ai)
#pragma unroll
            for (int m = 0; m < 4; ++m) { const int row = row0 + ai * HALF + m * 16;
                const float rstd = __builtin_amdgcn_rsqf(SS[row] * (1.0f / 1024.0f) + 1e-6f);
                f32x4 c = (f32x4){1.f, 1.f, 1.f, 1.f}, sn = (f32x4){0.f, 0.f, 0.f, 0.f};
                if (ropew) { c = *(const f32x4*)(cosp + (size_t)row * 8 + 4 * (fq & 1)); sn = *(const f32x4*)(sinp + (size_t)row * 8 + 4 * (fq & 1)); if (!ropel) { c = (f32x4){1.f, 1.f, 1.f, 1.f}; sn = (f32x4){0.f, 0.f, 0.f, 0.f}; } }
#pragma unroll
                for (int bj = 0; bj < 2; ++bj) { f32x4 a = acc[ai][bj][m][0] * rstd + bv[bj][0], b = acc[ai][bj][m][1] * rstd + bv[bj][1];
                    if (ropew) {
                        const f32x4 a2 = (f32x4){a[0] * c[0] - a[1] * sn[0], a[1] * c[0] + a[0] * sn[0], a[2] * c[1] - a[3] * sn[1], a[3] * c[1] + a[2] * sn[1]};
                        const f32x4 b2 = (f32x4){b[0] * c[2] - b[1] * sn[2], b[1] * c[2] + b[0] * sn[2], b[2] * c[3] - b[3] * sn[3], b[3] * c[3] + b[2] * sn[3]};
                        a = a2; b = b2; }
                    a = a * sc; b = b * sc;
                    u32x4 w; w.x = cvt_pk_bf16(a[0], a[1]); w.y = cvt_pk_bf16(a[2], a[3]); w.z = cvt_pk_bf16(b[0], b[1]); w.w = cvt_pk_bf16(b[2], b[3]);
                    const int col = col0 + bj * HALF, wi = col & 1023; const size_t bs = (size_t)(row >> 12), sq = (size_t)(row & 4095);
                    bf16_t* dst = (u.pn < 8) ? O + (size_t)(col >> 10) * 33554432 + ((bs * 16 + (wi >> 6)) * 4096 + sq) * 64 + (wi & 63)
                                             : O + (size_t)2 * 33554432 + ((bs * 8 + (wi >> 7)) * 4096 + sq) * 128 + (wi & 127);
                    *(u32x4*)dst = w; }
                asm volatile("" ::: "memory"); }
    }
};
}

#define LAS __attribute__((address_space(3)))
typedef unsigned short bf16_t;
typedef short bf16x8 __attribute__((ext_vector_type(8)));
typedef short s16x4 __attribute__((ext_vector_type(4)));
typedef float f32x4 __attribute__((ext_vector_type(4)));
typedef float f32x16 __attribute__((ext_vector_type(16)));
typedef unsigned u32x4 __attribute__((ext_vector_type(4)));
typedef unsigned u32x2 __attribute__((ext_vector_type(2)));
using pg8::cvt_pk_bf16;

constexpr int NB = 8, SEQ = 4096, T = NB * SEQ, D = 1024, DFF = 2816, INA = 1184, INA_P = 1280;
constexpr float EPS = 1e-6f;
constexpr float LOG2E = 1.4426950408889634f;
constexpr float LAMBDA_INIT = 0.35550907f;
constexpr size_t MiB = 1u << 20;
constexpr size_t WS_WIN = 0, WS_WUQ = 3 * MiB, WS_WUKV = 4 * MiB, WS_WPOOL = 5 * MiB, WS_WOA = 6 * MiB, WS_WOD = 8 * MiB, WS_WQKV = 10 * MiB,
                 WS_WGU0 = 16 * MiB, WS_WGU1 = 27 * MiB, WS_WD0 = 38 * MiB, WS_WD1 = 44 * MiB, WS_MOD = 50 * MiB, WS_COSR = 51 * MiB, WS_SINR = 53 * MiB,
                 WS_COSP = 55 * MiB, WS_SINP = 56 * MiB, WS_SMALL = 57 * MiB, WS_CTL = 58 * MiB;
constexpr int SM_N1G = 0, SM_N2G = 2048, SM_QNG = 4096, SM_KVNG = 4480, SM_POOLB = 4736, SM_POOLS = 5248, SM_LQ1 = 5760, SM_LK1 = 5824, SM_LQ2 = 5888, SM_LK2 = 5952, SM_SUBLN = 6016, SM_FNG = 6144, SM_TOTAL = 7168;
constexpr size_t WS_A = 64 * MiB;
constexpr size_t WS_PROJ = WS_A, WS_CQN = WS_A + 80 * MiB, WS_CKVN = WS_A + 104 * MiB, WS_KR = WS_A + 120 * MiB, WS_POOLED = WS_A + 122 * MiB, WS_KV = WS_A + 154 * MiB;
constexpr size_t WS_QM = WS_A, WS_H = WS_A, WS_QKV = WS_A;
constexpr size_t WS_STASH = 282 * MiB;
constexpr size_t WS_XN = 314 * MiB;
constexpr size_t WS_XR = 378 * MiB;
constexpr size_t WS_XA = 240 * MiB;
constexpr size_t WS_END = 506 * MiB;
constexpr size_t WS_ATAB = 59 * MiB, WS_BT = WS_ATAB + 128 * 1024, WS_SS = 60 * MiB;
constexpr int BT_GU0 = 0, BT_QKV = 8 * 5632, BT_GU1 = 8 * 5632 + 8 * 3072;

struct Params {
    const float *x, *c; const int* pos;
    const float *ada_w, *ada_b, *n1g, *n2g, *wgu, *wd, *w_in, *qng, *kvng, *wuq, *wukv, *pool_w, *pool_b, *pool_s, *wouta, *wqkv, *lq1, *lk1, *lq2, *lk2, *subln, *woutd, *fng;
    float* out; unsigned char* ws;
};

__device__ __forceinline__ int opq_tid() { int t = threadIdx.x; asm volatile("" : "+v"(t)); return t; }
__device__ __forceinline__ float wave_sum(float v) {
#pragma unroll
    for (int o = 1; o < 64; o <<= 1) v += __shfl_xor(v, o);
    return v;
}
__device__ __forceinline__ unsigned f2bf(float f) { unsigned u = __builtin_bit_cast(unsigned, f); return (u + 0x7fffu + ((u >> 16) & 1u)) >> 16; }
typedef float pkf32x2_t __attribute__((ext_vector_type(2))); typedef __bf16 pkbf16x2_t __attribute__((ext_vector_type(2)));
__device__ __forceinline__ unsigned pk2(float lo, float hi) { pkf32x2_t v = {lo, hi}; pkbf16x2_t b = __builtin_convertvector(v, pkbf16x2_t); return __builtin_bit_cast(unsigned, b); }
__device__ __forceinline__ float bf2f(unsigned short h) { return __builtin_bit_cast(float, (unsigned)h << 16); }
__device__ __forceinline__ float bflo(unsigned w) { return __builtin_bit_cast(float, w << 16); }
__device__ __forceinline__ float bfhi(unsigned w) { return __builtin_bit_cast(float, w & 0xffff0000u); }

__device__ __forceinline__ void tr_item(const float* W, int K, int N, bf16_t* WT, int ldd, int coloff, int roff, int mode, LAS float* scr, int item, int lane) {
    const int nblk = N / 32, kb = item / nblk, nb = item % nblk, k0 = 64 * kb, n0 = 32 * nb;
#pragma unroll 8
    for (int i = 0; i < 32; ++i) { const int kk = 2 * i + (lane >> 5); scr[kk * 33 + (lane & 31)] = W[(size_t)(k0 + kk) * N + n0 + (lane & 31)]; }
    asm volatile("s_waitcnt lgkmcnt(0)" ::: "memory");
    const int c = lane & 7;
#pragma unroll
    for (int j = 0; j < 4; ++j) { const int n = (lane >> 3) + 8 * j; const LAS float* s = scr + (8 * c) * 33 + n;
        u32x4 o; o.x = pk2(s[0 * 33], s[1 * 33]); o.y = pk2(s[2 * 33], s[3 * 33]); o.z = pk2(s[4 * 33], s[5 * 33]); o.w = pk2(s[6 * 33], s[7 * 33]);
        const int ng = n0 + n; int dr;
        if (mode == 1) { const int jj = (ng < DFF) ? ng : ng - DFF; dr = (jj >> 7) * 256 + (jj & 127) + ((ng < DFF) ? 0 : 128); }
        else if (mode == 2) { const int loc = ng & 63; dr = (ng < 2048 && loc < 16) ? (ng - loc) + ((loc & 7) >> 2) * 8 + (loc & 3) * 2 + (loc >> 3) : ng; }
        else if (mode == 3) { const int loc = ng % 96; dr = (loc >= 64) ? (ng - loc) + 64 + ((loc - 64 < 16) ? 2 * (loc - 64) : 2 * (loc - 80) + 1) : ng; }
        else dr = ng + roff;
        *(u32x4*)(WT + (size_t)dr * ldd + coloff + k0 + 8 * c) = o; }
    asm volatile("s_waitcnt lgkmcnt(0)" ::: "memory");
}

__device__ __forceinline__ void norm_pass(const float* src, const float* g, const float* mod, int sh_off, int sc_off, bf16_t* dst, int vcu, int G) {
    const int tid_ = opq_tid(), lane = tid_ & 63, gw = vcu * 8 + __builtin_amdgcn_readfirstlane(tid_ >> 6), ngw = G * 8;
    for (int row = gw; row < T; row += ngw) {
        const f32x4* xr = (const f32x4*)(src + (size_t)row * D) + lane;
        f32x4 v[4]; float s = 0.f;
#pragma unroll
        for (int j = 0; j < 4; ++j) { v[j] = xr[64 * j]; s += (v[j].x * v[j].x + v[j].y * v[j].y) + (v[j].z * v[j].z + v[j].w * v[j].w); }
        const float rstd = 1.0f / sqrtf(wave_sum(s) * (1.0f / D) + EPS);
        const float* mb = mod + (size_t)(row >> 12) * 6144;
        u32x2* o8 = (u32x2*)(dst + (size_t)row * D) + lane;
#pragma unroll
        for (int j = 0; j < 4; ++j) { const int col = 4 * lane + 256 * j;
            const f32x4 gg = *(const f32x4*)(g + col), sc = *(const f32x4*)(mb + sc_off + col), sh = *(const f32x4*)(mb + sh_off + col);
            const f32x4 y = v[j] * rstd * gg * (sc + 1.0f) + sh;
            u32x2 w; w.x = pk2(y.x, y.y); w.y = pk2(y.z, y.w); o8[64 * j] = w; }
    }
}
__device__ __forceinline__ void final_norm(const float* src, const float* g, float* dst, int vcu, int G) {
    const int tid_ = opq_tid(), lane = tid_ & 63, gw = vcu * 8 + __builtin_amdgcn_readfirstlane(tid_ >> 6), ngw = G * 8;
    for (int row = gw; row < T; row += ngw) {
        const f32x4* xr = (const f32x4*)(src + (size_t)row * D) + lane;
        f32x4 v[4]; float s = 0.f;
#pragma unroll
        for (int j = 0; j < 4; ++j) { v[j] = xr[64 * j]; s += (v[j].x * v[j].x + v[j].y * v[j].y) + (v[j].z * v[j].z + v[j].w * v[j].w); }
        const float rstd = 1.0f / sqrtf(wave_sum(s) * (1.0f / D) + EPS);
        f32x4* o = (f32x4*)(dst + (size_t)row * D) + lane;
#pragma unroll
        for (int j = 0; j < 4; ++j) { const f32x4 gg = *(const f32x4*)(g + 4 * lane + 256 * j); o[64 * j] = v[j] * rstd * gg; }
    }
}

__device__ __forceinline__ void mid_pass(const bf16_t* PROJ, const float* qng, const float* kvng, const float* cosr, const float* sinr,
                                         bf16_t* CQN, bf16_t* CKVN, bf16_t* KR, bf16_t* POOLED, int vcu, int G) {
    const int tid_ = opq_tid(), lane = tid_ & 63, gw = vcu * 8 + __builtin_amdgcn_readfirstlane(tid_ >> 6), ngw = G * 8;
    for (int row = gw; row < T; row += ngw) {
        const bf16_t* pr = PROJ + (size_t)row * INA_P; const int s = row & (SEQ - 1);
        {
            float a[3][2]; float ss = 0.f;
#pragma unroll
            for (int j = 0; j < 3; ++j) { const unsigned w = *(const unsigned*)(pr + 128 * j + 2 * lane); a[j][0] = bflo(w); a[j][1] = bfhi(w); ss += a[j][0] * a[j][0] + a[j][1] * a[j][1]; }
            const float rstd = 1.0f / sqrtf(wave_sum(ss) * (1.0f / 384.0f) + EPS);
#pragma unroll
            for (int j = 0; j < 3; ++j) { const int col = 128 * j + 2 * lane; *(unsigned*)(CQN + (size_t)row * 384 + col) = pk2(a[j][0] * rstd * qng[col], a[j][1] * rstd * qng[col + 1]); }
        }
        {
            const u32x2 w = *(const u32x2*)(pr + 384 + 4 * lane); const float a0 = bflo(w.x), a1 = bfhi(w.x), a2 = bflo(w.y), a3 = bfhi(w.y);
            const float rstd = 1.0f / sqrtf(wave_sum(a0 * a0 + a1 * a1 + a2 * a2 + a3 * a3) * (1.0f / 256.0f) + EPS);
            const f32x4 gg = *(const f32x4*)(kvng + 4 * lane);
            u32x2 o; o.x = pk2(a0 * rstd * gg.x, a1 * rstd * gg.y); o.y = pk2(a2 * rstd * gg.z, a3 * rstd * gg.w);
            *(u32x2*)(CKVN + (size_t)row * 256 + 4 * lane) = o;
        }
        if (lane < 16) {
            const float x1 = bf2f(pr[640 + lane]), x2 = bf2f(pr[656 + lane]), c = cosr[(size_t)row * 16 + lane], sn = sinr[(size_t)row * 16 + lane];
            *(unsigned*)(KR + (size_t)row * 32 + 2 * lane) = pk2(x1 * c - x2 * sn, x2 * c + x1 * sn);
        }
        {
            const int win = 2 << (lane >> 4); const bf16_t* up = pr + 672 + 8 * lane;
            const u32x4 cw = *(const u32x4*)up;
            float cur[8] = {bflo(cw.x), bfhi(cw.x), bflo(cw.y), bfhi(cw.y), bflo(cw.z), bfhi(cw.z), bflo(cw.w), bfhi(cw.w)};
            float sum[8];
#pragma unroll
            for (int e = 0; e < 8; ++e) sum[e] = cur[e];
            u32x4 pw[15];
#pragma unroll
            for (int w = 1; w < 16; ++w) { const int back = (w <= s) ? w : s; pw[w - 1] = *(const u32x4*)(up - (size_t)back * INA_P); }
#pragma unroll
            for (int w = 1; w < 16; ++w) { const float k = (w < win && w <= s) ? 1.0f : 0.0f; const u32x4 q = pw[w - 1];
                sum[0] += k * bflo(q.x); sum[1] += k * bfhi(q.x); sum[2] += k * bflo(q.y); sum[3] += k * bfhi(q.y); sum[4] += k * bflo(q.z); sum[5] += k * bfhi(q.z); sum[6] += k * bflo(q.w); sum[7] += k * bfhi(q.w); }
            const float ic = 1.0f / (float)((s + 1 < win) ? s + 1 : win);
            u32x4 o; o.x = pk2(sum[0] * ic - cur[0], sum[1] * ic - cur[1]); o.y = pk2(sum[2] * ic - cur[2], sum[3] * ic - cur[3]);
            o.z = pk2(sum[4] * ic - cur[4], sum[5] * ic - cur[5]); o.w = pk2(sum[6] * ic - cur[6], sum[7] * ic - cur[7]);
            *(u32x4*)(POOLED + (size_t)row * 512 + 8 * lane) = o;
        }
    }
}

typedef float f32x2_t __attribute__((ext_vector_type(2))); typedef __bf16 bf16x2_t __attribute__((ext_vector_type(2)));
__device__ __forceinline__ unsigned cvtpk_s(float lo, float hi) { f32x2_t v = {lo, hi}; bf16x2_t b = __builtin_convertvector(v, bf16x2_t); return __builtin_bit_cast(unsigned, b); }
#define MAX3F(a, b, c) __builtin_fmaxf(__builtin_fmaxf((a), (b)), (c))
constexpr float RESC_THR = 6.0f;
#define MFMA32(a, b, c) __builtin_amdgcn_mfma_f32_32x32x16_bf16((a), (b), (c), 0, 0, 0)
typedef short v4i16_t __attribute__((ext_vector_type(4)));
__device__ __forceinline__ s16x4 vtr(LAS const unsigned char* p) { return __builtin_bit_cast(s16x4, __builtin_amdgcn_ds_read_tr16_b64_v4i16((LAS v4i16_t*)p)); }

template <int DQK, int DV> struct AttnCfg {
    static constexpr int KP = DQK * 2 + 16, VP = DV * 2 + 64, KBYTES = 64 * KP, VBYTES = 64 * VP, OP = DV * 2 + 16;
    static constexpr int VOFF = 4 * KBYTES, OST = 0, RINGS = 4 * KBYTES + 4 * VBYTES, TOTAL = RINGS > 8 * 32 * OP ? RINGS : 8 * 32 * OP;
};
template <int ND, int KP>
__device__ __forceinline__ void qk_tile(LAS const unsigned char* kb, const bf16x8 (&qr)[ND], const f32x16& cinit, f32x16& p0, f32x16& p1) {
#pragma unroll
    for (int d0 = 0; d0 < ND; ++d0) {
        const bf16x8 a0 = *(LAS const bf16x8*)(kb + 32 * d0), a1 = *(LAS const bf16x8*)(kb + 32 * KP + 32 * d0);
        if (d0 == 0) { p0 = MFMA32(a0, qr[0], cinit); p1 = MFMA32(a1, qr[0], cinit); }
        else { p0 = MFMA32(a0, qr[d0], p0); p1 = MFMA32(a1, qr[d0], p1); }
    }
}
template <int DQK, int DKA, int DV>
__device__ __forceinline__ void attn_qblock(const bf16_t* __restrict__ Qp, int ldq, const bf16_t* __restrict__ KAp, int ldka, const bf16_t* __restrict__ KBp, int ldkb,
                                            const bf16_t* __restrict__ Vp, int ldv, int q0, LAS unsigned char* lds, f32x16 (&o)[DV / 32]) {
    typedef AttnCfg<DQK, DV> C;
    constexpr int KP = C::KP, VP = C::VP, ND = DQK / 16, NV = DV / 32, KCH = DQK / 8, NKC = 64 * KCH, KPT = (NKC + 511) / 512, VCH = DV / 8, NVC = 64 * VCH, VPT = NVC / 512;
    constexpr bool NEGM = true;
    const int tid = opq_tid(), lane = tid & 63, r32 = lane & 31, hi = lane >> 5, wid = __builtin_amdgcn_readfirstlane(tid >> 6);
    bf16x8 qr[ND];
    { const bf16_t* qrow = Qp + (size_t)(q0 + 32 * wid + r32) * ldq + 8 * hi;
#pragma unroll
      for (int d0 = 0; d0 < ND; ++d0) qr[d0] = *(const bf16x8*)(qrow + 16 * d0); }
    const int NT = (q0 + 256) / 64;
    static_assert(DKA == 64 && (DQK == 64 || DQK == 96), "staging map");
    constexpr bool HASB = (DQK > DKA);
    u32x4 kst[KPT], vst[VPT];
    const unsigned offA = (unsigned)((tid >> 3) * ldka + (tid & 7) * 8) * 2u, ldsA = (unsigned)((tid >> 3) * KP + (tid & 7) * 16);
    const unsigned offB = (unsigned)((tid >> 2) * ldkb + (tid & 3) * 8) * 2u, ldsB = (unsigned)((tid >> 2) * KP + DKA * 2 + (tid & 3) * 16);
    const unsigned offV = (unsigned)((tid / VCH) * ldv + (tid % VCH) * 8) * 2u, ldsV = (unsigned)((tid / VCH) * VP + (tid % VCH) * 16);
#define ATT_LOADK(t) do { kst[0] = *(const u32x4*)((const char*)KAp + (size_t)(t) * (size_t)(128 * ldka) + offA); \
    if (HASB) { if (tid < 256) kst[KPT - 1] = *(const u32x4*)((const char*)KBp + (size_t)(t) * (size_t)(128 * ldkb) + offB); } } while (0)
#define ATT_LOADV(t) do { _Pragma("unroll") for (int i = 0; i < VPT; ++i) vst[i] = *(const u32x4*)((const char*)Vp + ((size_t)(t) * 64 + (size_t)i * (512 / VCH)) * (size_t)(2 * ldv) + offV); } while (0)
#define ATT_STOREK(sl) do { *(LAS u32x4*)(lds + (sl) * C::KBYTES + ldsA) = kst[0]; \
    if (HASB) { if (tid < 256) *(LAS u32x4*)(lds + (sl) * C::KBYTES + ldsB) = kst[KPT - 1]; } } while (0)
#define ATT_STOREV(sl) do { _Pragma("unroll") for (int i = 0; i < VPT; ++i) *(LAS u32x4*)(lds + C::VOFF + (sl) * C::VBYTES + i * (512 / VCH) * VP + ldsV) = vst[i]; } while (0)
    __syncthreads();
    ATT_LOADK(0); ATT_LOADV(0); ATT_STOREK(0); ATT_STOREV(0);
    ATT_LOADK(1); ATT_LOADV(1); ATT_STOREK(1); ATT_STOREV(1);
    ATT_LOADK(2); ATT_STOREK(2);
    ATT_LOADK(3); ATT_LOADV(2);
    __syncthreads();
    float m = 0.f, l = 0.f; f32x16 negm;
#pragma unroll
    for (int i = 0; i < 16; ++i) negm[i] = 0.f;
#pragma unroll
    for (int v = 0; v < NV; ++v)
#pragma unroll
        for (int i = 0; i < 16; ++i) o[v][i] = 0.f;
    const int qabs = q0 + 32 * wid + r32, qlast = q0 + 32 * wid + 31;
    const int koff = r32 * KP + hi * 16;
    const int voff = (4 * hi + ((lane & 15) >> 2)) * VP + (16 * ((lane >> 4) & 1) + 4 * (lane & 3)) * 2;
    bf16x8 kf[2 * ND];
#define ATT_KFRAG(slot) do { LAS const unsigned char* kb_ = lds + (slot) * C::KBYTES + koff; \
    _Pragma("unroll") for (int d0 = 0; d0 < ND; ++d0) { kf[2 * d0] = *(LAS const bf16x8*)(kb_ + 32 * d0); kf[2 * d0 + 1] = *(LAS const bf16x8*)(kb_ + 32 * KP + 32 * d0); } } while (0)
#define ATT_VFRAG(vv) do { _Pragma("unroll") for (int j = 0; j < 2; ++j) _Pragma("unroll") for (int s4 = 0; s4 < 4; ++s4) { \
        vlo[j * 4 + s4] = vtr(vb + (16 * s4) * VP + 64 * ((vv) + j)); vhi[j * 4 + s4] = vtr(vb + (16 * s4 + 8) * VP + 64 * ((vv) + j)); } } while (0)
#define ATT_PV(vv) do { _Pragma("unroll") for (int s4 = 0; s4 < 4; ++s4) _Pragma("unroll") for (int j = 0; j < 2; ++j) { \
        const bf16x8 vf = __builtin_shufflevector(vlo[j * 4 + s4], vhi[j * 4 + s4], 0, 1, 2, 3, 4, 5, 6, 7); o[(vv) + j] = MFMA32(vf, pf[s4], o[(vv) + j]); } } while (0)
    ATT_KFRAG(0);
    for (int t = 0; t < NT; ++t) {
        const int ks1 = (t + 1) & 3;
        if (t + 3 < NT) ATT_STOREK((t + 3) & 3);
        if (t + 2 < NT) ATT_STOREV((t + 2) & 3);
        if (t + 4 < NT) ATT_LOADK(t + 4);
        if (t + 3 < NT) ATT_LOADV(t + 3);
        if (64 * t <= qlast) {
            f32x16 p0, p1; s16x4 vlo[8], vhi[8]; bf16x8 pf[4];
            LAS const unsigned char* vb = lds + C::VOFF + (t & 3) * C::VBYTES + voff;
            __builtin_amdgcn_sched_barrier(0);
            __builtin_amdgcn_s_setprio(1);
#pragma unroll
            for (int d0 = 0; d0 < ND; ++d0) {
                if (d0 == 0) { p0 = MFMA32(kf[0], qr[0], negm); p1 = MFMA32(kf[1], qr[0], negm); }
                else { p0 = MFMA32(kf[2 * d0], qr[d0], p0); p1 = MFMA32(kf[2 * d0 + 1], qr[d0], p1); }
            }
            __builtin_amdgcn_s_setprio(0);
            __builtin_amdgcn_sched_barrier(0);
            ATT_VFRAG(0);
            __builtin_amdgcn_sched_barrier(0);
            if (64 * t + 63 > q0 + 32 * wid) {
                const int kvb = 64 * t + 4 * hi;
#pragma unroll
                for (int i = 0; i < 16; ++i) { const int kv = kvb + (i & 3) + 8 * (i >> 2); if (kv > qabs) p0[i] = -INFINITY; if (kv + 32 > qabs) p1[i] = -INFINITY; }
            }
            float mxa = MAX3F(p0[0], p0[1], p1[0]), mxb = MAX3F(p0[2], p0[3], p1[1]); mxa = MAX3F(mxa, p1[2], p1[3]);
#pragma unroll
            for (int i = 4; i < 16; i += 4) { mxa = MAX3F(mxa, p0[i], p0[i + 1]); mxb = MAX3F(mxb, p0[i + 2], p0[i + 3]); mxa = MAX3F(mxa, p1[i], p1[i + 1]); mxb = MAX3F(mxb, p1[i + 2], p1[i + 3]); }
            float mx = fmaxf(mxa, mxb);
            { auto rr = __builtin_amdgcn_permlane32_swap(__float_as_uint(mx), __float_as_uint(mx), false, false); mx = fmaxf(__uint_as_float(rr[0]), __uint_as_float(rr[1])); }
            if (!NEGM) mx -= m;
            if (t == 0) {
                m = mx;
                if (NEGM) {
#pragma unroll
                    for (int i = 0; i < 16; ++i) { p0[i] -= mx; p1[i] -= mx; }
#pragma unroll
                    for (int i = 0; i < 16; ++i) negm[i] = -m;
                }
            } else if (__any(mx > RESC_THR)) {
                const float dl = fmaxf(mx, 0.f), alpha = __builtin_amdgcn_exp2f(-dl); m += dl;
                if (NEGM) {
#pragma unroll
                    for (int i = 0; i < 16; ++i) { p0[i] -= dl; p1[i] -= dl; }
#pragma unroll
                    for (int i = 0; i < 16; ++i) negm[i] = -m;
                }
                l *= alpha;
#pragma unroll
                for (int v = 0; v < NV; ++v)
#pragma unroll
                    for (int i = 0; i < 16; ++i) o[v][i] *= alpha;
            }
            { float rs = 0.f;
#pragma unroll
              for (int i = 0; i < 16; ++i) { p0[i] = __builtin_amdgcn_exp2f(NEGM ? p0[i] : p0[i] - m); p1[i] = __builtin_amdgcn_exp2f(NEGM ? p1[i] : p1[i] - m); rs += p0[i] + p1[i]; }
              l += rs;
#pragma unroll
              for (int s = 0; s < 2; ++s) { u32x4 w0, w1;
                w0.x = cvtpk_s(p0[8 * s], p0[8 * s + 1]); w0.y = cvtpk_s(p0[8 * s + 2], p0[8 * s + 3]); w0.z = cvtpk_s(p0[8 * s + 4], p0[8 * s + 5]); w0.w = cvtpk_s(p0[8 * s + 6], p0[8 * s + 7]);
                w1.x = cvtpk_s(p1[8 * s], p1[8 * s + 1]); w1.y = cvtpk_s(p1[8 * s + 2], p1[8 * s + 3]); w1.z = cvtpk_s(p1[8 * s + 4], p1[8 * s + 5]); w1.w = cvtpk_s(p1[8 * s + 6], p1[8 * s + 7]);
                pf[s] = __builtin_bit_cast(bf16x8, w0); pf[2 + s] = __builtin_bit_cast(bf16x8, w1); } }
            __builtin_amdgcn_sched_barrier(0);
            if (NV == 2) {
                __builtin_amdgcn_s_setprio(1); ATT_PV(0); __builtin_amdgcn_s_setprio(0);
                __builtin_amdgcn_sched_barrier(0);
                if (t + 1 < NT) ATT_KFRAG(ks1);
            } else {
                __builtin_amdgcn_s_setprio(1); ATT_PV(0); __builtin_amdgcn_s_setprio(0);
                __builtin_amdgcn_sched_barrier(0);
                ATT_VFRAG(2);
                __builtin_amdgcn_sched_barrier(0);
                __builtin_amdgcn_s_setprio(1); ATT_PV(2); __builtin_amdgcn_s_setprio(0);
                __builtin_amdgcn_sched_barrier(0);
                if (t + 1 < NT) ATT_KFRAG(ks1);
            }
            __builtin_amdgcn_sched_barrier(0);
        }
        if (t & 1) asm volatile("s_waitcnt lgkmcnt(0)\n\ts_barrier" ::: "memory");
    }
#undef ATT_KFRAG
#undef ATT_VFRAG
#undef ATT_PV
#undef ATT_LOADK
#undef ATT_LOADV
#undef ATT_STOREK
#undef ATT_STOREV
    l += __shfl_xor(l, 32);
    const float il = 1.0f / l;
#pragma unroll
    for (int v = 0; v < NV; ++v)
#pragma unroll
        for (int i = 0; i < 16; ++i) o[v][i] *= il;
}
template <int DQK, int DV>
__device__ __forceinline__ void attn_store(const f32x16 (&o)[DV / 32], bf16_t* dst, int ldo, LAS unsigned char* lds) {
    typedef AttnCfg<DQK, DV> C; constexpr int OP = C::OP, NV = DV / 32;
    const int tid = opq_tid(), lane = tid & 63, r32 = lane & 31, hi = lane >> 5, wid = __builtin_amdgcn_readfirstlane(tid >> 6);
    LAS unsigned char* ost = lds + C::OST + wid * (32 * OP);
#pragma unroll
    for (int v = 0; v < NV; ++v)
#pragma unroll
        for (int g = 0; g < 4; ++g) { u32x2 w; w.x = cvt_pk_bf16(o[v][4 * g], o[v][4 * g + 1]); w.y = cvt_pk_bf16(o[v][4 * g + 2], o[v][4 * g + 3]);
            *(LAS u32x2*)(ost + r32 * OP + (32 * v + 8 * g + 4 * hi) * 2) = w; }
    asm volatile("s_waitcnt lgkmcnt(0)" ::: "memory");
#pragma unroll
    for (int k = 0; k < DV / 16; ++k) { const int c = lane + 64 * k, row = c / (DV / 8), ch = c % (DV / 8);
        const u32x4 v = *(LAS const u32x4*)(ost + row * OP + ch * 16); *(u32x4*)(dst + (size_t)(32 * wid + row) * ldo + ch * 8) = v; }
    asm volatile("s_waitcnt lgkmcnt(0)" ::: "memory");
}

#define XB_TMO      128
#define XB_XCNT(j)  (256  + 64 * (j))
#define XB_XSUB(j)  (1280 + 64 * (j))
#define XB_XGEN(j)  (2304 + 64 * (j))
#define XB_TOP      3328
#define XB_TOPGEN   3392
#define XCD_BAR_WORDS 3456
#define XB_SPIN_CAP (1u << 18)

__device__ __forceinline__ unsigned xb_ld(unsigned* p)              { return __hip_atomic_load(p, __ATOMIC_RELAXED, __HIP_MEMORY_SCOPE_AGENT); }
__device__ __forceinline__ unsigned xb_add(unsigned* p, unsigned v) { return __hip_atomic_fetch_add(p, v, __ATOMIC_RELAXED, __HIP_MEMORY_SCOPE_AGENT); }
__device__ __forceinline__ unsigned xb_xcc_id() { return (unsigned)__builtin_amdgcn_s_getreg((3 << 11) | 20) & 0xFu; }
#define XB_SPIN(cond, bar) do { unsigned _sp = 0; while (cond) { __builtin_amdgcn_s_sleep(1); \
    if ((++_sp & 255u) == 0u) { if (xb_ld(&(bar)[XB_TMO])) break; if (_sp > XB_SPIN_CAP) { atomicAdd(&(bar)[XB_TMO], 1u); break; } } } } while (0)

struct XcdBarrier {
    unsigned* bar; unsigned x;
    volatile LAS unsigned* st;
};

__device__ __forceinline__ XcdBarrier xcd_barrier_post(unsigned* bar, volatile LAS unsigned* st) {
    XcdBarrier b; b.bar = bar; b.x = xb_xcc_id(); b.st = st;
    if (threadIdx.x == 0) (void)xb_add(&bar[XB_XCNT(b.x)], 1u);
    return b;
}
__device__ __forceinline__ void xcd_barrier_complete(unsigned* bar, unsigned x, unsigned& nloc, unsigned& nx) {
    const unsigned G = gridDim.x * gridDim.y * gridDim.z;
    unsigned sum, cnt, mine, sp = 0u;
    for (;;) {
        sum = 0u; cnt = 0u; mine = 0u;
#pragma unroll
        for (unsigned j = 0; j < 16; ++j) { const unsigned c = xb_ld(&bar[XB_XCNT(j)]); sum += c; cnt += (c > 0u) ? 1u : 0u; mine = (j == x) ? c : mine; }
        if (sum == G) break;
        __builtin_amdgcn_s_sleep(1);
        if ((++sp & 255u) == 0u) { if (xb_ld(&bar[XB_TMO])) break; if (sp > XB_SPIN_CAP) { atomicAdd(&bar[XB_TMO], 1u); break; } }
    }
    nloc = mine > 0u ? mine : 1u; nx = cnt > 0u ? cnt : 1u;
}

__device__ __forceinline__ void xcd_barrier(const XcdBarrier& b) {
    asm volatile("s_waitcnt vmcnt(0)" ::: "memory");
    __syncthreads();
    if (threadIdx.x == 0) {
        unsigned* bar = b.bar;
        __builtin_amdgcn_s_waitcnt(0);
        unsigned nloc = b.st[0], nx = b.st[1];
        if (nloc == 0u) { xcd_barrier_complete(bar, b.x, nloc, nx); b.st[0] = nloc; b.st[1] = nx; }
        const unsigned old = xb_add(&bar[XB_XSUB(b.x)], 1u);
        const unsigned gen = old / nloc;
        if (old + 1u == (gen + 1u) * nloc) {
            __builtin_amdgcn_fence(__ATOMIC_RELEASE, "agent");
            asm volatile("s_waitcnt vmcnt(0)" ::: "memory");
            const unsigned og = xb_add(&bar[XB_TOP], 1u);
            const unsigned tg = og / nx;
            if (og + 1u == (tg + 1u) * nx) xb_add(&bar[XB_TOPGEN], 1u);
            else XB_SPIN(xb_ld(&bar[XB_TOPGEN]) == tg, bar);
            __builtin_amdgcn_fence(__ATOMIC_ACQUIRE, "agent");
            xb_add(&bar[XB_XGEN(b.x)], 1u);
            asm volatile("s_waitcnt vmcnt(0)" ::: "memory");
        } else {
            XB_SPIN(xb_ld(&bar[XB_XGEN(b.x)]) == gen, bar);
            __builtin_amdgcn_fence(__ATOMIC_ACQUIRE, "agent");
            asm volatile("s_waitcnt vmcnt(0)" ::: "memory");
        }
    }
    __syncthreads();
}

constexpr int LDS_BYTES = 147456;
static_assert(AttnCfg<96, 64>::TOTAL <= LDS_BYTES - 64 && AttnCfg<64, 128>::TOTAL <= LDS_BYTES - 64, "attention LDS");

__global__ void __launch_bounds__(512, 2) fwd_megakernel(Params p) {
    extern __shared__ __attribute__((aligned(16))) unsigned char lds_raw[];
    LAS unsigned char* lds = (LAS unsigned char*)lds_raw;
    cg::grid_group grid = cg::this_grid();
    const int G = gridDim.x, bx = blockIdx.x;
    const int vcu = (G % 8 == 0) ? (bx % 8) * (G / 8) + bx / 8 : bx;
    unsigned char* ws = p.ws;
    unsigned* BARW = (unsigned*)(ws + WS_CTL);
    volatile LAS unsigned* bst = (volatile LAS unsigned*)(lds + LDS_BYTES - 64);
    if (threadIdx.x < 2) bst[threadIdx.x] = 0u;
    if (bx == 0) for (int i = threadIdx.x; i < XCD_BAR_WORDS; i += 512) BARW[i] = 0u;
    __syncthreads();
    bf16_t* WIN = (bf16_t*)(ws + WS_WIN); bf16_t* WUQ = (bf16_t*)(ws + WS_WUQ); bf16_t* WUKV = (bf16_t*)(ws + WS_WUKV); bf16_t* WPOOL = (bf16_t*)(ws + WS_WPOOL);
    bf16_t* WOA = (bf16_t*)(ws + WS_WOA); bf16_t* WOD = (bf16_t*)(ws + WS_WOD); bf16_t* WQKV = (bf16_t*)(ws + WS_WQKV);
    bf16_t* WGU0 = (bf16_t*)(ws + WS_WGU0); bf16_t* WGU1 = (bf16_t*)(ws + WS_WGU1); bf16_t* WD0 = (bf16_t*)(ws + WS_WD0); bf16_t* WD1 = (bf16_t*)(ws + WS_WD1);
    float* MOD = (float*)(ws + WS_MOD); float* COSR = (float*)(ws + WS_COSR); float* SINR = (float*)(ws + WS_SINR); float* COSP = (float*)(ws + WS_COSP); float* SINP = (float*)(ws + WS_SINP);
    bf16_t* PROJ = (bf16_t*)(ws + WS_PROJ); bf16_t* CQN = (bf16_t*)(ws + WS_CQN); bf16_t* CKVN = (bf16_t*)(ws + WS_CKVN); bf16_t* KR = (bf16_t*)(ws + WS_KR);
    bf16_t* POOLED = (bf16_t*)(ws + WS_POOLED); bf16_t* KV = (bf16_t*)(ws + WS_KV); bf16_t* QM = (bf16_t*)(ws + WS_QM); bf16_t* HB = (bf16_t*)(ws + WS_H); bf16_t* QKV = (bf16_t*)(ws + WS_QKV);
    bf16_t* XN = (bf16_t*)(ws + WS_XN); float* XR = (float*)(ws + WS_XR); float* STASH = (float*)(ws + WS_STASH); float* SM = (float*)(ws + WS_SMALL);
    bf16_t* XA = (bf16_t*)(ws + WS_XA); float* ATAB = (float*)(ws + WS_ATAB); float* BT = (float*)(ws + WS_BT); float* SS = (float*)(ws + WS_SS);

    {
        const int tid = opq_tid(), lane = tid & 63, wave = __builtin_amdgcn_readfirstlane(tid >> 6), gw = vcu * 8 + wave, ngw = G * 8;
        LAS float* sc = (LAS float*)lds;
        LAS float* red = (LAS float*)(lds + 32768);
        for (int i = tid; i < NB * D; i += 512) { const float v = p.c[i]; sc[i] = v / (1.0f + __expf(-v)); }
        __syncthreads();
        for (int item = vcu; item < 192; item += G) {
            const int l = item / 96, col = (item % 96) * 64 + lane;
            const float* w = p.ada_w + (size_t)l * D * 6144 + col;
            float acc[8] = {0.f, 0.f, 0.f, 0.f, 0.f, 0.f, 0.f, 0.f};
            const int k0 = wave * 128;
#pragma unroll 8
            for (int k = 0; k < 128; ++k) { const float wv = w[(size_t)(k0 + k) * 6144];
#pragma unroll
                for (int b = 0; b < 8; ++b) acc[b] += sc[b * D + k0 + k] * wv; }
#pragma unroll
            for (int b = 0; b < 8; ++b) red[(wave * 8 + b) * 64 + lane] = acc[b];
            __syncthreads();
            { float s = 0.f;
#pragma unroll
              for (int w8 = 0; w8 < 8; ++w8) s += red[(w8 * 8 + wave) * 64 + lane];
              MOD[(size_t)(l * 8 + wave) * 6144 + col] = s + p.ada_b[l * 6144 + col]; }
            __syncthreads();
        }
        __syncthreads();
        LAS float* scr = (LAS float*)(lds + wave * 16384);
        constexpr int I_IN = 16 * 37, I_UQ = 6 * 24, I_UKV = 4 * 32, I_POOL = 2 * 4, I_O = 16 * 32, I_QKV = 16 * 96, I_GU = 16 * 176, I_D = 44 * 32;
        constexpr int NITEMS = I_IN + I_UQ + I_UKV + 4 * I_POOL + 2 * I_O + I_QKV + 2 * I_GU + 2 * I_D;
        for (int it = gw; it < NITEMS; it += ngw) {
            int r = it;
            if (r < I_IN) { tr_item(p.w_in, D, INA, WIN, D, 0, 0, 0, scr, r, lane); continue; } r -= I_IN;
            if (r < I_UQ) { tr_item(p.wuq, 384, 768, WUQ, 384, 0, 0, 3, scr, r, lane); continue; } r -= I_UQ;
            if (r < I_UKV) { tr_item(p.wukv, 256, 1024, WUKV, 256, 0, 0, 0, scr, r, lane); continue; } r -= I_UKV;
            if (r < 4 * I_POOL) { const int g = r / I_POOL; tr_item(p.pool_w + (size_t)g * 128 * 128, 128, 128, WPOOL, 512, g * 128, g * 128, 0, scr, r % I_POOL, lane); continue; } r -= 4 * I_POOL;
            if (r < I_O) { tr_item(p.wouta, D, D, WOA, D, 0, 0, 0, scr, r, lane); continue; } r -= I_O;
            if (r < I_O) { tr_item(p.woutd, D, D, WOD, D, 0, 0, 0, scr, r, lane); continue; } r -= I_O;
            if (r < I_QKV) { tr_item(p.wqkv, D, 3072, WQKV, D, 0, 0, 2, scr, r, lane); continue; } r -= I_QKV;
            if (r < I_GU) { tr_item(p.wgu, D, 2 * DFF, WGU0, D, 0, 0, 1, scr, r, lane); continue; } r -= I_GU;
            if (r < I_GU) { tr_item(p.wgu + (size_t)D * 2 * DFF, D, 2 * DFF, WGU1, D, 0, 0, 1, scr, r, lane); continue; } r -= I_GU;
            if (r < I_D) { tr_item(p.wd, DFF, D, WD0, DFF, 0, 0, 0, scr, r, lane); continue; } r -= I_D;
            tr_item(p.wd + (size_t)DFF * D, DFF, D, WD1, DFF, 0, 0, 0, scr, r, lane);
        }
        const int gt = vcu * 512 + tid, ngt = G * 512;
        for (int i = gt; i < (INA_P - INA) * D / 8; i += ngt) ((u32x4*)(WIN + (size_t)INA * D))[i] = (u32x4){0u, 0u, 0u, 0u};
        for (int i = gt; i < 3 * T / 4; i += ngt) ((f32x4*)SS)[i] = (f32x4){0.f, 0.f, 0.f, 0.f};
        for (int i = gt; i < 512 * 64; i += ngt) { const int row = i >> 6, c8 = i & 63; if ((row >> 7) != (c8 >> 4)) ((u32x4*)WPOOL)[i] = (u32x4){0u, 0u, 0u, 0u}; }
        for (int i = gt; i < SM_TOTAL; i += ngt) {
            float v;
            if (i < SM_N2G) v = p.n1g[i]; else if (i < SM_QNG) v = p.n2g[i - SM_N2G]; else if (i < SM_KVNG) v = p.qng[i - SM_QNG]; else if (i < SM_POOLB) v = p.kvng[i - SM_KVNG];
            else if (i < SM_POOLS) v = p.pool_b[i - SM_POOLB]; else if (i < SM_LQ1) v = p.pool_s[i - SM_POOLS]; else if (i < SM_LK1) v = p.lq1[i - SM_LQ1]; else if (i < SM_LQ2) v = p.lk1[i - SM_LK1];
            else if (i < SM_LK2) v = p.lq2[i - SM_LQ2]; else if (i < SM_SUBLN) v = p.lk2[i - SM_LK2]; else if (i < SM_FNG) v = p.subln[i - SM_SUBLN]; else v = p.fng[i - SM_FNG];
            SM[i] = v;
        }
        for (int t = gt; t < T; t += ngt) {
            const float pf = (float)p.pos[t];
#pragma unroll
            for (int i = 0; i < 16; ++i) { const float ang = pf * exp2f(-(float)(2 * i) / 32.0f * 18.931568569324174f); double rev = (double)ang * 0.15915494309189535; rev -= rint(rev);
                COSR[(size_t)t * 16 + i] = __builtin_amdgcn_cosf((float)rev); SINR[(size_t)t * 16 + i] = __builtin_amdgcn_sinf((float)rev); }
#pragma unroll
            for (int i = 0; i < 8; ++i) { const float ang = pf * exp2f(-(float)(2 * i) / 16.0f * 18.931568569324174f); double rev = (double)ang * 0.15915494309189535; rev -= rint(rev);
                COSP[(size_t)t * 8 + i] = __builtin_amdgcn_cosf((float)rev); SINP[(size_t)t * 8 + i] = __builtin_amdgcn_sinf((float)rev); }
        }
    }
    grid.sync();
    const XcdBarrier xbar = xcd_barrier_post(BARW, bst);

    const float* mod0 = MOD; const float* mod1 = MOD + 8 * 6144;
    {
        const int tid = opq_tid(), lane = tid & 63, wave = __builtin_amdgcn_readfirstlane(tid >> 6), gw = vcu * 8 + wave, ngw = G * 8, gt = vcu * 512 + tid, ngt = G * 512;
        for (int i = gt; i < 3 * 8 * 1024; i += ngt) { const int k = i >> 13, b = (i >> 10) & 7, c = i & 1023;
            const float g = (k == 0) ? SM[SM_N2G + c] : (k == 1) ? SM[SM_N1G + 1024 + c] : SM[SM_N2G + 1024 + c];
            const float sc = (k == 0) ? mod0[b * 6144 + 4096 + c] : (k == 1) ? mod1[b * 6144 + 1024 + c] : mod1[b * 6144 + 4096 + c];
            ATAB[i] = g * (1.0f + sc); }
        for (int r = gw; r < 5632 + 3072 + 5632; r += ngw) {
            const bf16_t* wrow; const float* sh; float* dst; int ncol;
            if (r < 5632) { wrow = WGU0 + (size_t)r * 1024; sh = mod0 + 3072; dst = BT + BT_GU0 + r; ncol = 5632; }
            else if (r < 5632 + 3072) { wrow = WQKV + (size_t)(r - 5632) * 1024; sh = mod1; dst = BT + BT_QKV + (r - 5632); ncol = 3072; }
            else { wrow = WGU1 + (size_t)(r - 5632 - 3072) * 1024; sh = mod1 + 3072; dst = BT + BT_GU1 + (r - 5632 - 3072); ncol = 5632; }
            const u32x4 w0 = *(const u32x4*)(wrow + 16 * lane), w1 = *(const u32x4*)(wrow + 16 * lane + 8);
            const float wf[16] = {bflo(w0.x), bfhi(w0.x), bflo(w0.y), bfhi(w0.y), bflo(w0.z), bfhi(w0.z), bflo(w0.w), bfhi(w0.w), bflo(w1.x), bfhi(w1.x), bflo(w1.y), bfhi(w1.y), bflo(w1.z), bfhi(w1.z), bflo(w1.w), bfhi(w1.w)};
#pragma unroll
            for (int b = 0; b < 8; ++b) { const f32x4* sp = (const f32x4*)(sh + b * 6144 + 16 * lane); float a = 0.f;
#pragma unroll
                for (int j = 0; j < 4; ++j) { const f32x4 sv = sp[j]; a += sv[0] * wf[4 * j] + sv[1] * wf[4 * j + 1] + sv[2] * wf[4 * j + 2] + sv[3] * wf[4 * j + 3]; }
                a = wave_sum(a); if (lane == 0) dst[(size_t)b * ncol] = a; }
        }
    }
    norm_pass(p.x, SM + SM_N1G, mod0, 0, 1024, XN, vcu, G);
    xcd_barrier(xbar);
    { pg8::Gemm g{XN, WIN, T, INA_P, D}; pg8::StaticOrder S; S.init(T, INA_P, G, bx); pg8::EpiStore E{PROJ, INA_P, nullptr, nullptr};
      pg8::gemm_phase<pg8::EpiStore, pg8::StaticOrder, true, true>(lds, g, S, E); }
    xcd_barrier(xbar);
    mid_pass(PROJ, SM + SM_QNG, SM + SM_KVNG, COSR, SINR, CQN, CKVN, KR, POOLED, vcu, G);
    xcd_barrier(xbar);
    { pg8::Gemm g{CQN, WUQ, T, 768, 384}; pg8::StaticOrder S; S.init(T, 768, G, bx); pg8::EpiQMla E{QM, COSR, SINR, 0.10206207261596577f * LOG2E};
      pg8::gemm_phase<pg8::EpiQMla, pg8::StaticOrder, true, true>(lds, g, S, E); }
    { pg8::Gemm g{CKVN, WUKV, T, 1024, 256}; pg8::StaticOrder S; S.init(T, 1024, G, bx); pg8::EpiKvHead E{KV};
      pg8::gemm_phase<pg8::EpiKvHead, pg8::StaticOrder, true, true>(lds, g, S, E); }
    { pg8::Gemm g{POOLED, WPOOL, T, 512, 512}; pg8::StaticOrder S; S.init(T, 512, G, bx); pg8::EpiStore E{XN + 512, 1024, SM + SM_POOLB, SM + SM_POOLS};
      pg8::gemm_phase<pg8::EpiStore, pg8::StaticOrder, true, true>(lds, g, S, E); }
    xcd_barrier(xbar);
    for (int u = vcu; u < NB * 8 * 8; u += G) {
        const int pair = u & 7, bh = u >> 3, b = bh >> 3, h = bh & 7;
        for (int half = 0; half < 2; ++half) {
            const int q0 = (half == 0 ? 15 - pair : pair) * 256;
            f32x16 o[2];
            attn_qblock<96, 64, 64>(QM + (size_t)bh * SEQ * 96, 96, KV + (size_t)bh * SEQ * 64, 64, KR + (size_t)b * SEQ * 32, 32,
                                    KV + 16777216 + (size_t)bh * SEQ * 64, 64, q0, lds, o);
            attn_store<96, 64>(o, XN + (size_t)(b * SEQ + q0) * 1024 + h * 64, 1024, lds);
        }
    }
    xcd_barrier(xbar);
    { pg8::Gemm g{XN, WOA, T, D, D}; pg8::StaticOrder S; S.init(T, D, G, bx); pg8::EpiResN E{p.x, XR, mod0 + 2048, 6144, XA, ATAB, SS};
      pg8::gemm_phase<pg8::EpiResN, pg8::StaticOrder, true, true>(lds, g, S, E); }
    xcd_barrier(xbar);
    { pg8::Gemm g{XA, WGU0, T, 2 * DFF, D}; pg8::StaticOrder S; S.init(T, 2 * DFF, G, bx); pg8::EpiSwiglu E{HB, DFF, SS, BT + BT_GU0};
      pg8::gemm_phase<pg8::EpiSwiglu, pg8::StaticOrder, true, true>(lds, g, S, E); }
    xcd_barrier(xbar);
    { pg8::Gemm g{HB, WD0, T, D, DFF}; pg8::StaticOrder S; S.init(T, D, G, bx); pg8::EpiResN E{XR, XR, mod0 + 5120, 6144, XN, ATAB + 8192, SS + T};
      pg8::gemm_phase<pg8::EpiResN, pg8::StaticOrder, true, true>(lds, g, S, E); }
    xcd_barrier(xbar);
    { pg8::Gemm g{XN, WQKV, T, 3072, D}; pg8::StaticOrder S; S.init(T, 3072, G, bx); pg8::EpiQkvDiff E{QKV, COSP, SINP, 0.125f * LOG2E, SS + T, BT + BT_QKV};
      pg8::gemm_phase<pg8::EpiQkvDiff, pg8::StaticOrder, true, true>(lds, g, S, E); }
    xcd_barrier(xbar);
    {
        float d1 = 0.f, d2 = 0.f;
        for (int i = 0; i < 64; ++i) { d1 += SM[SM_LQ1 + i] * SM[SM_LK1 + i]; d2 += SM[SM_LQ2 + i] * SM[SM_LK2 + i]; }
        const float lam = expf(d1) - expf(d2) + LAMBDA_INIT;
        float* stash = STASH + (size_t)bx * (64 * 512);
        const int tid = opq_tid(), hi = (tid & 63) >> 5;
        for (int u = vcu; u < NB * 8 * 8; u += G) {
            const int pair = u & 7, bh = u >> 3, b = bh >> 3, h = bh & 7;
            for (int half = 0; half < 2; ++half) {
                const int q0 = (half == 0 ? 15 - pair : pair) * 256;
                f32x16 o[4];
#pragma unroll 1
                for (int c = 0; c < 2; ++c) {
                    attn_qblock<64, 64, 128>(QKV + (size_t)(b * 16 + 2 * h + c) * SEQ * 64, 64, QKV + 33554432 + (size_t)(b * 16 + 2 * h + c) * SEQ * 64, 64, QKV, 64,
                                             QKV + (size_t)2 * 33554432 + (size_t)bh * SEQ * 128, 128, q0, lds, o);
                    if (c == 0) {
                        float* sp = stash + tid * 4;
#pragma unroll
                        for (int v = 0; v < 4; ++v)
#pragma unroll
                            for (int g4 = 0; g4 < 4; ++g4) { *(f32x4*)sp = (f32x4){o[v][4 * g4], o[v][4 * g4 + 1], o[v][4 * g4 + 2], o[v][4 * g4 + 3]}; sp += 2048; asm volatile("" : "+v"(sp)); }
                    }
                }
                float ss = 0.f; const float* sq = stash + tid * 4;
#pragma unroll
                for (int v = 0; v < 4; ++v) {
#pragma unroll
                    for (int g4 = 0; g4 < 4; ++g4) { const f32x4 sv = *(const f32x4*)sq; sq += 2048; asm volatile("" : "+v"(sq));
#pragma unroll
                        for (int e = 0; e < 4; ++e) { const float d = sv[e] - lam * o[v][4 * g4 + e]; o[v][4 * g4 + e] = d; ss += d * d; } }
                    asm volatile("" ::: "memory"); }
                ss += __shfl_xor(ss, 32);
                const float rstd = (1.0f - LAMBDA_INIT) / sqrtf(ss * (1.0f / 128.0f) + EPS);
#pragma unroll
                for (int v = 0; v < 4; ++v)
#pragma unroll
                    for (int g4 = 0; g4 < 4; ++g4) { const f32x4 gv = *(const f32x4*)(SM + SM_SUBLN + 32 * v + 8 * g4 + 4 * hi);
#pragma unroll
                        for (int e = 0; e < 4; ++e) o[v][4 * g4 + e] *= rstd * gv[e]; }
                attn_store<64, 128>(o, XN + (size_t)(b * SEQ + q0) * 1024 + h * 128, 1024, lds);
            }
        }
    }
    xcd_barrier(xbar);
    { pg8::Gemm g{XN, WOD, T, D, D}; pg8::StaticOrder S; S.init(T, D, G, bx); pg8::EpiResN E{XR, XR, mod1 + 2048, 6144, XA, ATAB + 2 * 8192, SS + 2 * T};
      pg8::gemm_phase<pg8::EpiResN, pg8::StaticOrder, true, true>(lds, g, S, E); }
    xcd_barrier(xbar);
    { pg8::Gemm g{XA, WGU1, T, 2 * DFF, D}; pg8::StaticOrder S; S.init(T, 2 * DFF, G, bx); pg8::EpiSwiglu E{HB, DFF, SS + 2 * T, BT + BT_GU1};
      pg8::gemm_phase<pg8::EpiSwiglu, pg8::StaticOrder, true, true>(lds, g, S, E); }
    xcd_barrier(xbar);
    { pg8::Gemm g{HB, WD1, T, D, DFF}; pg8::StaticOrder S; S.init(T, D, G, bx); pg8::EpiRes E{XR, XR, mod1 + 5120, 6144};
      pg8::gemm_phase<pg8::EpiRes, pg8::StaticOrder, true, true>(lds, g, S, E); }
    xcd_barrier(xbar);
    final_norm(XR, SM + SM_FNG, p.out, vcu, G);
}

extern "C" void kernel_launch(void* const* d_in, const int* in_sizes, int n_in, void* d_out, int out_size, void* d_ws, size_t ws_size, hipStream_t stream) {
    static int grid = 0;
    if (grid == 0) {
        if (n_in != 26 || in_sizes[0] != T * D || out_size != T * D || ws_size < WS_END) { fprintf(stderr, "kernel_launch: unexpected shapes (n_in %d, in0 %d, out %d, ws %zu)\n", n_in, n_in > 0 ? in_sizes[0] : -1, out_size, ws_size); grid = -1; return; }
        int dev = 0, cus = 0, per_cu = 0;
        if (hipGetDevice(&dev) != hipSuccess || hipDeviceGetAttribute(&cus, hipDeviceAttributeMultiprocessorCount, dev) != hipSuccess) { grid = -1; return; }
        if (hipFuncSetAttribute((const void*)fwd_megakernel, hipFuncAttributeMaxDynamicSharedMemorySize, LDS_BYTES) != hipSuccess) { fprintf(stderr, "kernel_launch: hipFuncSetAttribute failed\n"); grid = -1; return; }
        if (hipOccupancyMaxActiveBlocksPerMultiprocessor(&per_cu, (const void*)fwd_megakernel, 512, LDS_BYTES) != hipSuccess || per_cu < 1) { fprintf(stderr, "kernel_launch: occupancy query gave %d\n", per_cu); per_cu = 1; }
        (void)hipGetLastError();
        grid = cus * (per_cu > 1 ? 1 : per_cu);
    }
    if (grid < 0) return;
    Params p{};
    p.x = (const float*)d_in[0]; p.c = (const float*)d_in[1]; p.pos = (const int*)d_in[2];
    p.ada_w = (const float*)d_in[3]; p.ada_b = (const float*)d_in[4]; p.n1g = (const float*)d_in[5]; p.n2g = (const float*)d_in[6];
    p.wgu = (const float*)d_in[7]; p.wd = (const float*)d_in[8]; p.w_in = (const float*)d_in[9]; p.qng = (const float*)d_in[10]; p.kvng = (const float*)d_in[11];
    p.wuq = (const float*)d_in[12]; p.wukv = (const float*)d_in[13]; p.pool_w = (const float*)d_in[14]; p.pool_b = (const float*)d_in[15]; p.pool_s = (const float*)d_in[16];
    p.wouta = (const float*)d_in[17]; p.wqkv = (const float*)d_in[18]; p.lq1 = (const float*)d_in[19]; p.lk1 = (const float*)d_in[20]; p.lq2 = (const float*)d_in[21]; p.lk2 = (const float*)d_in[22];
    p.subln = (const float*)d_in[23]; p.woutd = (const float*)d_in[24]; p.fng = (const float*)d_in[25];
    p.out = (float*)d_out; p.ws = (unsigned char*)d_ws;
    void* args[] = {&p};
    hipError_t e = hipLaunchCooperativeKernel((const void*)fwd_megakernel, dim3(grid), dim3(512), args, LDS_BYTES, stream);
    if (e != hipSuccess) fprintf(stderr, "kernel_launch: cooperative launch failed: %s (grid %d)\n", hipGetErrorString(e), grid);
}
```
